# Optimizing an MI355X kernel written in HIP

```python
import math
import jax
import jax.numpy as jnp
from jax import lax
import numpy as np

D_MODEL = 2048
BATCH = 8
SEQ = 2048
DEPTH = 2

GRID_W = 64
CTX_LEN = 256
MIX_WIDTH = 2 * D_MODEL
GATE_WIDTH = MIX_WIDTH
DIFF_V = 128
DIFF_HEADS = D_MODEL // DIFF_V
DIFF_QK = DIFF_V // 2
MLSTM_V = 256
MLSTM_HEADS = D_MODEL // MLSTM_V
MLSTM_QK = MLSTM_V // 2
RET_HEADS = 8
RET_DK = D_MODEL // RET_HEADS
RET_DV = D_MODEL // RET_HEADS
MLA_HEADS = 16
MLA_NOPE = 128
MLA_ROPE = 64
MLA_V = D_MODEL // MLA_HEADS
MLA_Q_LORA = D_MODEL // 4
MLA_KV_LORA = D_MODEL // 8

CHUNK = 64
Q_BLOCK = 128
ROPE_BASE = 10000.0
NORM_EPS = 1e-5

AB_SPLITS = (DIFF_HEADS * 2 * DIFF_QK, DIFF_HEADS * 2 * DIFF_QK, DIFF_HEADS * DIFF_V,
             MLSTM_HEADS * MLSTM_QK, MLSTM_HEADS * MLSTM_QK, MLSTM_HEADS * MLSTM_V,
             MLSTM_HEADS * MLSTM_V, 2 * MLSTM_HEADS, 2 * MLSTM_HEADS, GATE_WIDTH)
CD_SPLITS = (RET_HEADS * RET_DK, RET_HEADS * RET_DK, RET_HEADS * RET_DV,
             MLA_Q_LORA, MLA_KV_LORA, MLA_ROPE, GATE_WIDTH)

kernel_name = 'hybrid_diffattn_mlstm_retention_mla_dit'

F32 = jnp.float32


def split_cols(a, sizes):
    return jnp.split(a, [int(s) for s in np.cumsum(sizes)[:-1]], axis=-1)


def heads(a, n_heads):
    b, l, _ = a.shape
    return a.reshape(b, l, n_heads, -1).transpose(0, 2, 1, 3)


def merge_heads(a):
    b, h, l, d = a.shape
    return a.transpose(0, 2, 1, 3).reshape(b, l, h * d)


def layer_norm(x, g, b):
    xf = x.astype(F32)
    xc = xf - xf.mean(-1, keepdims=True)
    y = xc * lax.rsqrt((xc * xc).mean(-1, keepdims=True) + NORM_EPS)
    return (y * g + b).astype(x.dtype)


def rms_norm(x, g):
    xf = x.astype(F32)
    y = xf * lax.rsqrt((xf * xf).mean(-1, keepdims=True) + NORM_EPS)
    return (y * g).astype(x.dtype)


def head_layer_norm(a, g):
    af = a.astype(F32)
    ac = af - af.mean(-1, keepdims=True)
    y = ac * lax.rsqrt((ac * ac).mean(-1, keepdims=True) + NORM_EPS)
    return (merge_heads(y) * g).astype(g.dtype)


def head_rms_norm(a, g):
    af = a.astype(F32)
    y = af * lax.rsqrt((af * af).mean(-1, keepdims=True) + NORM_EPS)
    return (merge_heads(y) * g).astype(g.dtype)


def axial_rope(n_tokens, rot_dim):
    n_rows = n_tokens // GRID_W
    t = jnp.arange(n_tokens)
    row = jnp.repeat(jnp.arange(n_rows), GRID_W).astype(F32)
    col = (t % GRID_W).astype(F32)
    n_freq = rot_dim // 4
    inv_freq = ROPE_BASE ** (-jnp.arange(n_freq, dtype=F32) / n_freq)
    ang = jnp.concatenate([row[:, None] * inv_freq, col[:, None] * inv_freq], axis=-1)
    return jnp.cos(ang), jnp.sin(ang)


def apply_rope(x, rope):
    cos, sin = (t.astype(x.dtype) for t in rope)
    x1, x2 = jnp.split(x, 2, axis=-1)
    return jnp.concatenate([x1 * cos - x2 * sin, x1 * sin + x2 * cos], axis=-1)


def over_query_blocks(fn, *qs):
    b, h, l, _ = qs[0].shape
    nb = l // Q_BLOCK
    blocks = tuple(jnp.moveaxis(q.reshape(b, h, nb, Q_BLOCK, q.shape[-1]), 2, 0) for q in qs)
    out = lax.map(lambda bl: fn(*bl), blocks)
    return jnp.moveaxis(out, 0, 2).reshape(b, h, l, out.shape[-1])


def softmax_attention(q, k, v, scale):
    def block(qb):
        s = jnp.einsum('bhqd,bhkd->bhqk', qb, k).astype(F32) * scale
        return jnp.einsum('bhqk,bhkd->bhqd', jax.nn.softmax(s, axis=-1).astype(v.dtype), v)
    return over_query_blocks(block, q)


def diff_attention(q1, q2, k1, k2, v, lam):
    scale = q1.shape[-1] ** -0.5

    def block(a1, a2):
        s1 = jnp.einsum('bhqd,bhkd->bhqk', a1, k1).astype(F32) * scale
        s2 = jnp.einsum('bhqd,bhkd->bhqk', a2, k2).astype(F32) * scale
        p = jax.nn.softmax(s1, axis=-1) - lam * jax.nn.softmax(s2, axis=-1)
        return jnp.einsum('bhqk,bhkd->bhqd', p.astype(v.dtype), v)
    return over_query_blocks(block, q1, q2)


def to_chunks(a):
    b, h, l = a.shape[:3]
    return jnp.moveaxis(a.reshape((b, h, l // CHUNK, CHUNK) + a.shape[3:]), 2, 0)


def from_chunks(a):
    a = jnp.moveaxis(a, 0, 2)
    return a.reshape(a.shape[:2] + (a.shape[2] * a.shape[3],) + a.shape[4:])


def mlstm_scan(seqs, state):
    lower = jnp.tril(jnp.ones((CHUNK, CHUNK), dtype=bool))

    def step(carry, xs):
        c_st, n_st, m_st = carry
        qc, kc, vc, ic, fc = xs
        b = jnp.cumsum(fc, axis=-1)
        d = jnp.where(lower, b[..., :, None] - b[..., None, :] + ic[..., None, :], -jnp.inf)
        inter = b + m_st[..., None]
        m_t = jnp.maximum(d.max(-1), inter)
        w = jnp.exp(d - m_t[..., None])
        a = jnp.exp(inter - m_t)
        s = jnp.einsum('bhtd,bhsd->bhts', qc, kc) * w
        num = a[..., None] * jnp.einsum('bhtd,bhdv->bhtv', qc, c_st) + jnp.einsum('bhts,bhsv->bhtv', s, vc)
        den = a * jnp.einsum('bhtd,bhd->bht', qc, n_st) + s.sum(-1)
        h = num / jnp.maximum(jnp.abs(den), jnp.exp(-m_t))[..., None]
        b_end = b[..., -1]
        g = b_end[..., None] - b + ic
        m_new = jnp.maximum(b_end + m_st, g.max(-1))
        decay = jnp.exp(b_end + m_st - m_new)
        wk = jnp.exp(g - m_new[..., None])
        c_st = decay[..., None, None] * c_st + jnp.einsum('bhs,bhsd,bhsv->bhdv', wk, kc, vc)
        n_st = decay[..., None] * n_st + jnp.einsum('bhs,bhsd->bhd', wk, kc)
        return (c_st, n_st, m_new), h

    state, hs = lax.scan(step, state, tuple(to_chunks(a) for a in seqs))
    return from_chunks(hs), state


def retention_scan(seqs, log_gamma, state):
    q_seq = seqs
    pos = jnp.arange(CHUNK, dtype=F32)
    rel = pos[:, None] - pos[None, :]
    decay = jnp.where(rel >= 0, jnp.exp(log_gamma[:, None, None] * jnp.maximum(rel, 0.0)), 0.0)
    q_decay = jnp.exp(log_gamma[:, None] * (pos + 1.0))[..., None]
    k_decay = jnp.exp(log_gamma[:, None] * (CHUNK - 1.0 - pos))
    chunk_decay = jnp.exp(log_gamma * CHUNK)[:, None, None]

    def step(s_st, xs):
        qc, kc, vc = xs
        scores = jnp.einsum('bhtd,bhsd->bhts', qc, kc) * decay
        out = jnp.einsum('bhts,bhsv->bhtv', scores, vc) + q_decay * jnp.einsum('bhtd,bhdv->bhtv', qc, s_st)
        s_st = chunk_decay * s_st + jnp.einsum('hs,bhsd,bhsv->bhdv', k_decay, kc, vc)
        return s_st, out

    state, outs = lax.scan(step, state, tuple(to_chunks(a) for a in q_seq))
    return from_chunks(outs), state


def bidirectional_scan(scan_fwd, scan_bwd, lat_f, lat_b, ctx_f, ctx_b, state0):
    flip = lambda seqs: tuple(jnp.flip(a, axis=2) for a in seqs)
    hc_f, st_f = scan_fwd(ctx_f, state0)
    hl_f, _ = scan_fwd(lat_f, st_f)
    hc_b, st_b = scan_bwd(flip(ctx_b), state0)
    hl_b, _ = scan_bwd(flip(lat_b), st_b)
    return hl_f + jnp.flip(hl_b, axis=2), hc_f + jnp.flip(hc_b, axis=2)


def diff_mlstm_sublayer(h, hc, w_in, b_if, lam_vec, diff_g, mlstm_g, w_out, lam_init, rope, need_ctx):
    lat = split_cols(h @ w_in, AB_SPLITS)
    cx = split_cols(hc @ w_in, AB_SPLITS)

    lv = lam_vec.astype(F32)
    lam = jnp.exp(jnp.sum(lv[0] * lv[1])) - jnp.exp(jnp.sum(lv[2] * lv[3])) + lam_init

    def diff_qkv(parts, rope_t):
        q1, q2 = jnp.split(heads(parts[0], DIFF_HEADS), 2, axis=-1)
        k1, k2 = jnp.split(heads(parts[1], DIFF_HEADS), 2, axis=-1)
        if rope_t is not None:
            q1, q2, k1, k2 = (apply_rope(t, rope_t) for t in (q1, q2, k1, k2))
        return q1, q2, k1, k2, heads(parts[2], DIFF_HEADS)

    q1, q2, k1, k2, v = diff_qkv(lat, rope)
    cq1, cq2, ck1, ck2, cv = diff_qkv(cx, None)
    cat = lambda a, b: jnp.concatenate([a, b], axis=2)
    a_lat = diff_attention(q1, q2, cat(ck1, k1), cat(ck2, k2), cat(cv, v), lam)

    def mlstm_seqs(parts):
        bt, lt, _ = parts[0].shape
        q = heads(parts[3], MLSTM_HEADS).astype(F32) * MLSTM_QK ** -0.5
        k = heads(parts[4], MLSTM_HEADS).astype(F32)
        vv = heads(parts[5], MLSTM_HEADS).astype(F32)
        gi = (parts[7].reshape(bt, lt, 2, MLSTM_HEADS) + b_if[:2]).astype(F32).transpose(2, 0, 3, 1)
        gf = jax.nn.log_sigmoid((parts[8].reshape(bt, lt, 2, MLSTM_HEADS) + b_if[2:]).astype(F32)).transpose(2, 0, 3, 1)
        return (q, k, vv, gi[0], gf[0]), (q, k, vv, gi[1], gf[1])

    lat_f, lat_b = mlstm_seqs(lat)
    ctx_f, ctx_b = mlstm_seqs(cx)
    bsz = h.shape[0]
    state0 = (jnp.zeros((bsz, MLSTM_HEADS, MLSTM_QK, MLSTM_V), F32),
              jnp.zeros((bsz, MLSTM_HEADS, MLSTM_QK), F32),
              jnp.zeros((bsz, MLSTM_HEADS), F32))
    m_lat, m_ctx = bidirectional_scan(mlstm_scan, mlstm_scan, lat_f, lat_b, ctx_f, ctx_b, state0)

    def combine(a_out, m_out, parts):
        a_n = head_rms_norm(a_out, diff_g) * (1.0 - lam_init)
        m_n = head_layer_norm(m_out, mlstm_g) * jax.nn.sigmoid(parts[6])
        return (jnp.concatenate([a_n, m_n], axis=-1) * jax.nn.silu(parts[9])) @ w_out

    y = combine(a_lat, m_lat, lat)
    yc = combine(diff_attention(cq1, cq2, ck1, ck2, cv, lam), m_ctx, cx) if need_ctx else None
    return y, yc


def retention_mla_sublayer(h, hc, w_in, ret_decay, ret_g, q_norm_g, w_uq, kv_norm_g, w_ukv, w_out,
                           rope_ret, rope_mla, need_ctx):
    lat = split_cols(h @ w_in, CD_SPLITS)
    cx = split_cols(hc @ w_in, CD_SPLITS)

    def ret_seqs(parts, rope_t):
        q = heads(parts[0], RET_HEADS)
        k = heads(parts[1], RET_HEADS)
        if rope_t is not None:
            q, k = apply_rope(q, rope_t), apply_rope(k, rope_t)
        return (q.astype(F32), k.astype(F32) * RET_DK ** -0.5, heads(parts[2], RET_HEADS).astype(F32))

    lg = jax.nn.log_sigmoid(ret_decay.astype(F32))
    lat_s = ret_seqs(lat, rope_ret)
    ctx_s = ret_seqs(cx, None)
    state0 = jnp.zeros((h.shape[0], RET_HEADS, RET_DK, RET_DV), F32)
    r_lat, r_ctx = bidirectional_scan(lambda s, st: retention_scan(s, lg[0], st),
                                      lambda s, st: retention_scan(s, lg[1], st),
                                      lat_s, lat_s, ctx_s, ctx_s, state0)

    def mla_qkv(parts, rope_t):
        q_nope, q_rope = jnp.split(heads(rms_norm(parts[3], q_norm_g) @ w_uq, MLA_HEADS), [MLA_NOPE], axis=-1)
        k_nope, vv = jnp.split(heads(rms_norm(parts[4], kv_norm_g) @ w_ukv, MLA_HEADS), [MLA_NOPE], axis=-1)
        k_rope = parts[5][:, None]
        if rope_t is not None:
            q_rope, k_rope = apply_rope(q_rope, rope_t), apply_rope(k_rope, rope_t)
        k_rope = jnp.broadcast_to(k_rope, k_nope.shape[:3] + (MLA_ROPE,))
        return jnp.concatenate([q_nope, q_rope], axis=-1), jnp.concatenate([k_nope, k_rope], axis=-1), vv

    q, k, v = mla_qkv(lat, rope_mla)
    cq, ck, cv = mla_qkv(cx, None)
    scale = (MLA_NOPE + MLA_ROPE) ** -0.5
    d_lat = softmax_attention(q, jnp.concatenate([ck, k], axis=2), jnp.concatenate([cv, v], axis=2), scale)

    def combine(r_out, d_out, parts):
        mixed = jnp.concatenate([head_layer_norm(r_out, ret_g), merge_heads(d_out)], axis=-1)
        return (mixed * jax.nn.silu(parts[6])) @ w_out

    y = combine(r_lat, d_lat, lat)
    yc = combine(r_ctx, softmax_attention(cq, ck, cv, scale), cx) if need_ctx else None
    return y, yc


def setup_inputs(seed: int = 0) -> dict:
    key = jax.random.key(seed)
    ks = jax.random.split(key, 22)
    n_even = (DEPTH + 1) // 2
    n_odd = DEPTH // 2
    beta = (8.0 * DEPTH) ** -0.25

    def nrm(k, shape, s):
        return jax.random.normal(k, shape, F32) * s

    def gain(k, shape):
        return 1.0 + nrm(k, shape, 0.01)

    ab_in = int(sum(AB_SPLITS))
    cd_in = int(sum(CD_SPLITS))
    f_bias = jnp.linspace(3.0, 6.0, MLSTM_HEADS, dtype=F32)
    i_bias = jnp.full((MLSTM_HEADS,), -2.0, F32)
    if_base = jnp.stack([i_bias, i_bias, f_bias, f_bias])
    gamma = 1.0 - 2.0 ** (-5.0 - np.arange(RET_HEADS, dtype=np.float32))
    ret_logit = jnp.asarray(np.log(gamma / (1.0 - gamma)), F32)
    return {
        'x': nrm(ks[0], (BATCH, SEQ, D_MODEL), 1.0),
        'c': nrm(ks[1], (BATCH, D_MODEL), 1.0),
        'ctx': nrm(ks[2], (BATCH, CTX_LEN, D_MODEL), 1.0),
        'c_ctx': nrm(ks[3], (D_MODEL,), 1.0),
        'ada_w': nrm(ks[4], (DEPTH, D_MODEL, 3 * D_MODEL), D_MODEL ** -0.5),
        'ada_b': nrm(ks[5], (DEPTH, 3 * D_MODEL), 0.01),
        'ln_g': gain(ks[6], (DEPTH, D_MODEL)),
        'ln_b': nrm(ks[7], (DEPTH, D_MODEL), 0.01),
        'ab_w_in': nrm(ks[8], (n_even, D_MODEL, ab_in), D_MODEL ** -0.5),
        'ab_b_if': if_base + nrm(ks[9], (n_even, 4, MLSTM_HEADS), 0.1),
        'diff_lam': nrm(ks[10], (n_even, 4, DIFF_QK), 0.1),
        'diff_norm_g': gain(ks[11], (n_even, DIFF_HEADS * DIFF_V)),
        'mlstm_norm_g': gain(ks[12], (n_even, MLSTM_HEADS * MLSTM_V)),
        'ab_w_out': nrm(ks[13], (n_even, MIX_WIDTH, D_MODEL), beta * MIX_WIDTH ** -0.5),
        'cd_w_in': nrm(ks[14], (n_odd, D_MODEL, cd_in), D_MODEL ** -0.5),
        'ret_decay': ret_logit + nrm(ks[15], (n_odd, 2, RET_HEADS), 0.01),
        'ret_norm_g': gain(ks[16], (n_odd, RET_HEADS * RET_DV)),
        'mla_q_norm_g': gain(ks[17], (n_odd, MLA_Q_LORA)),
        'mla_w_uq': nrm(ks[18], (n_odd, MLA_Q_LORA, MLA_HEADS * (MLA_NOPE + MLA_ROPE)), MLA_Q_LORA ** -0.5),
        'mla_kv_norm_g': gain(ks[19], (n_odd, MLA_KV_LORA)),
        'mla_w_ukv': nrm(ks[20], (n_odd, MLA_KV_LORA, MLA_HEADS * (MLA_NOPE + MLA_V)), MLA_KV_LORA ** -0.5),
        'cd_w_out': nrm(ks[21], (n_odd, MIX_WIDTH, D_MODEL), beta * MIX_WIDTH ** -0.5),
    }


def reference(x, c, ctx, c_ctx, ada_w, ada_b, ln_g, ln_b,
              ab_w_in, ab_b_if, diff_lam, diff_norm_g, mlstm_norm_g, ab_w_out,
              cd_w_in, ret_decay, ret_norm_g, mla_q_norm_g, mla_w_uq, mla_kv_norm_g, mla_w_ukv, cd_w_out):
    alpha = (2.0 * DEPTH) ** 0.25
    n_lat = x.shape[1]
    rope_diff = axial_rope(n_lat, DIFF_QK)
    rope_ret = axial_rope(n_lat, RET_DK)
    rope_mla = axial_rope(n_lat, MLA_ROPE)
    sc = jax.nn.silu(c)
    scc = jax.nn.silu(c_ctx)
    xc = ctx
    for layer in range(DEPTH):
        need_ctx = layer < DEPTH - 1
        shift, scale, gate = jnp.split(sc @ ada_w[layer] + ada_b[layer], 3, axis=-1)
        shift_c, scale_c, gate_c = jnp.split(scc @ ada_w[layer] + ada_b[layer], 3, axis=-1)
        h = x * (1.0 + scale[:, None]) + shift[:, None]
        hc = xc * (1.0 + scale_c) + shift_c
        i = layer // 2
        if layer % 2 == 0:
            lam_init = 0.8 - 0.6 * math.exp(-0.3 * layer)
            y, yc = diff_mlstm_sublayer(h, hc, ab_w_in[i], ab_b_if[i], diff_lam[i], diff_norm_g[i],
                                        mlstm_norm_g[i], ab_w_out[i], lam_init, rope_diff, need_ctx)
        else:
            y, yc = retention_mla_sublayer(h, hc, cd_w_in[i], ret_decay[i], ret_norm_g[i], mla_q_norm_g[i],
                                           mla_w_uq[i], mla_kv_norm_g[i], mla_w_ukv[i], cd_w_out[i],
                                           rope_ret, rope_mla, need_ctx)
        x = layer_norm(alpha * x + gate[:, None] * y, ln_g[layer], ln_b[layer])
        if need_ctx:
            xc = layer_norm(alpha * xc + gate_c * yc, ln_g[layer], ln_b[layer])
    return x
```

```cpp
#include <hip/hip_runtime.h>
#include <hip/hip_cooperative_groups.h>
#include <cstdio>
#include <cstdint>
namespace cg = cooperative_groups;
#ifndef MULTI
#define MULTI 1
#endif

#define DI __device__ __forceinline__
typedef unsigned short bfu;
typedef __attribute__((ext_vector_type(8))) short bf16x8;
typedef __attribute__((ext_vector_type(4))) short bf16x4;
typedef __attribute__((ext_vector_type(16))) float f32x16;
typedef __attribute__((ext_vector_type(4))) float f32x4;
typedef __attribute__((ext_vector_type(4))) unsigned u32x4;
typedef __attribute__((ext_vector_type(2))) unsigned u32x2;
#define MFMA(a, b, c) __builtin_amdgcn_mfma_f32_32x32x16_bf16((a), (b), (c), 0, 0, 0)

constexpr int NB = 8, SEQ = 2048, CTX = 256, T = 2304, DM = 2048, MROWS = NB * T;
constexpr int GB = 2, NG = 4, MG = GB * T;
constexpr int N1 = 16512, N2 = 11136;
constexpr float LOG2E = 1.4426950408889634f;
constexpr float EPS = 1e-5f;
constexpr float ALPHA = 1.4142135623730951f;
constexpr int NT = 256;
constexpr int BK = 64, LDT = BK + 8;
constexpr int SMEM_BYTES = 2 * 2 * 128 * LDT * 2;
constexpr int CLD = 132;

struct Params {
  const float *x, *c, *ctx, *c_ctx, *ada_w, *ada_b, *ln_g, *ln_b, *ab_w_in, *ab_b_if, *diff_lam, *diff_g, *mlstm_g, *ab_w_out,
      *cd_w_in, *ret_decay, *ret_g, *q_norm_g, *w_uq, *kv_norm_g, *w_ukv, *cd_w_out;
  float* out;
  float* ZX; bfu* WA; bfu* WO1; float* mod; float* cs64; float* cs256; int* ctr;
  bfu* G;
};

constexpr size_t U = (size_t)MG * 2048 * 2;
constexpr size_t L0_QD = 0, L0_KD = U, L0_VT = 2 * U, L0_MQ = 3 * U, L0_MK = 3 * U + U / 2, L0_MKT = 4 * U, L0_MVT = 4 * U + U / 2,
                 L0_OG = 5 * U + U / 2, L0_GATE = 6 * U + U / 2, L0_OA = 8 * U + U / 2, L0_HN = 10 * U + U / 2, L0_SM = 12 * U + U / 2;
constexpr size_t L0_MIX = L0_QD, L0_H = L0_OA;
constexpr size_t L1_RQ = 0, L1_RK = U, L1_RKT = 2 * U, L1_RVT = 3 * U, L1_GATE = 4 * U, L1_Q = 6 * U, L1_K = 7 * U + U / 2, L1_VT = 9 * U,
                 L1_OA = 10 * U, L1_R = 11 * U, L1_QL = 13 * U, L1_KVL = 13 * U + U / 4, L1_SM = 13 * U + U / 2;
constexpr size_t L1_MIX = L1_RQ, L1_H = L1_OA;
constexpr size_t GREGION = 14 * U;
constexpr size_t SM_GI = 0, SM_GF = 2 * GB * 8 * T * 4, SM_DN = 2 * SM_GF, SM_SSQ = 3 * SM_GF, SM_SSK = SM_SSQ + (size_t)MG * 4 * 4;

constexpr size_t WS_ZX = 0;
constexpr size_t WS_WA = WS_ZX + (size_t)MROWS * 2048 * 4;
constexpr size_t WS_WO1 = WS_WA + (size_t)N1 * 2048 * 2;
constexpr size_t WS_MOD = WS_WO1 + (size_t)2048 * 4096 * 2;
constexpr size_t WS_CS64 = WS_MOD + 2 * 9 * 6144 * 4;
constexpr size_t WS_CS256 = WS_CS64 + 2048 * 32 * 2 * 4;
constexpr size_t WS_CTR = WS_CS256 + 2048 * 128 * 2 * 4;
constexpr size_t WS_G = WS_CTR + 1024;
constexpr size_t WS_END = WS_G + GREGION;
constexpr size_t WA_W2 = 0, WA_WO2 = (size_t)N2 * 2048 * 2, WA_UQ = WA_WO2 + (size_t)2048 * 4096 * 2, WA_UKV = WA_UQ + (size_t)3072 * 512 * 2;

DI int crow(int r, int hi) { return (r & 3) + 8 * (r >> 2) + 4 * hi; }
DI unsigned cvtpk(float lo, float hi) { unsigned r; asm("v_cvt_pk_bf16_f32 %0, %1, %2" : "=v"(r) : "v"(lo), "v"(hi)); return r; }
DI float bf2f(bfu v) { return __uint_as_float((unsigned)v << 16); }
DI float bflo(unsigned v) { return __uint_as_float(v << 16); }
DI float bfhi(unsigned v) { return __uint_as_float(v & 0xffff0000u); }
DI bf16x8 pack8f(const float* v) { u32x4 w = {cvtpk(v[0], v[1]), cvtpk(v[2], v[3]), cvtpk(v[4], v[5]), cvtpk(v[6], v[7])}; return __builtin_bit_cast(bf16x8, w); }
DI bf16x8 packacc(const f32x16& x, int s) {
  u32x4 w = {cvtpk(x[8 * s], x[8 * s + 1]), cvtpk(x[8 * s + 2], x[8 * s + 3]), cvtpk(x[8 * s + 4], x[8 * s + 5]), cvtpk(x[8 * s + 6], x[8 * s + 7])};
  return __builtin_bit_cast(bf16x8, w);
}
DI bf16x8 ld8(const bfu* p) { return *reinterpret_cast<const bf16x8*>(p); }
DI bf16x8 ld44(const bfu* p) {
  u32x2 a = *reinterpret_cast<const u32x2*>(p), b = *reinterpret_cast<const u32x2*>(p + 8);
  u32x4 w = {a[0], a[1], b[0], b[1]}; return __builtin_bit_cast(bf16x8, w);
}
DI void st8(bfu* p, bf16x8 v) { *reinterpret_cast<bf16x8*>(p) = v; }
DI void unpack8(bf16x8 v, float* f) { u32x4 w = __builtin_bit_cast(u32x4, v); for (int i = 0; i < 4; ++i) { f[2 * i] = bflo(w[i]); f[2 * i + 1] = bfhi(w[i]); } }
DI float silu(float v) { return v / (1.f + __expf(-v)); }
DI float sigm(float v) { return 1.f / (1.f + __expf(-v)); }
DI float logsig(float v) { return fminf(v, 0.f) - log1pf(__expf(-fabsf(v))); }
DI float wsum(float v) { for (int o = 32; o > 0; o >>= 1) v += __shfl_xor(v, o); return v; }
DI float wmax(float v) { for (int o = 32; o > 0; o >>= 1) v = fmaxf(v, __shfl_xor(v, o)); return v; }
DI float block_sum(float v, float* red) {
  v = wsum(v);
  __syncthreads();
  if ((threadIdx.x & 63) == 0) red[threadIdx.x >> 6] = v;
  __syncthreads();
  return red[0] + red[1] + red[2] + red[3];
}

DI int srccol1(int n) { return n < 12288 ? n : (n < 16384 ? n + 32 : (n < 16416 ? n - 4096 : -1)); }
DI int srccol2(int n) {
  if (n < 4096) { int base = n & ~255, j = n & 255, grp = j >> 6, w = j & 63; return base + (grp & 1) * 128 + (grp >> 1) * 64 + w; }
  if (n < 6976) return n;
  if (n < 7040) return -1;
  return n - 64;
}
DI void tr_tile(const float* __restrict__ src, int ld, int K, int mapid, const float* __restrict__ ks, bfu* __restrict__ dst, int tile, float* tl) {
  const int tid = threadIdx.x;
  const int kT = K >> 6, nt = tile / kT, kt = tile % kT, n0 = nt * 64, k0 = kt * 64;
  __syncthreads();
  {
    int n = n0 + (tid & 63);
    int sc = mapid == 1 ? srccol1(n) : (mapid == 2 ? srccol2(n) : n);
    for (int i = 0; i < 16; ++i) {
      int k = i * 4 + (tid >> 6);
      float v = sc >= 0 ? src[(long)(k0 + k) * ld + sc] : 0.f;
      if (ks) v *= ks[k0 + k];
      tl[k * 65 + (tid & 63)] = v;
    }
  }
  __syncthreads();
  for (int i = 0; i < 2; ++i) {
    int n = i * 32 + (tid >> 3), k8 = (tid & 7) * 8;
    float v[8];
    for (int j = 0; j < 8; ++j) v[j] = tl[(k8 + j) * 65 + n];
    st8(dst + (long)(n0 + n) * K + k0 + k8, pack8f(v));
  }
}

DI void phase_prep0(const Params& p, char* smem) {
  float* tl = (float*)smem;
  const int tid = threadIdx.x, G_ = gridDim.x, b = blockIdx.x;
  if (b == 0 && tid < 64) p.ctr[tid] = 0;
  for (int it = b; it < 192; it += G_) {
    int layer = it / 96, cg_ = it % 96, col = cg_ * 64 + (tid & 63), kq = tid >> 6;
    const float* w = p.ada_w + (long)layer * 2048 * 6144;
    float acc[9];
    for (int r = 0; r < 9; ++r) acc[r] = 0.f;
    for (int k = kq * 512; k < kq * 512 + 512; ++k) {
      float wv = w[(long)k * 6144 + col];
      for (int r = 0; r < 8; ++r) acc[r] += silu(p.c[r * 2048 + k]) * wv;
      acc[8] += silu(p.c_ctx[k]) * wv;
    }
    __syncthreads();
    for (int r = 0; r < 9; ++r) tl[(kq * 9 + r) * 64 + (tid & 63)] = acc[r];
    __syncthreads();
    if (tid < 64) {
      for (int r = 0; r < 9; ++r) {
        float s = tl[r * 64 + tid] + tl[(9 + r) * 64 + tid] + tl[(18 + r) * 64 + tid] + tl[(27 + r) * 64 + tid];
        p.mod[((long)layer * 9 + r) * 6144 + col] = s + p.ada_b[layer * 6144 + col];
      }
    }
  }
  for (int i = b * NT + tid; i < 2048 * 160; i += G_ * NT) {
    int pos = i / 160, j = i % 160;
    float row = (float)(pos >> 6), col = (float)(pos & 63);
    if (j < 32) {
      int f = j & 15; float inv = powf(10000.f, -(float)f / 16.f); float ang = (j < 16 ? row : col) * inv;
      p.cs64[(pos * 32 + j) * 2] = cosf(ang); p.cs64[(pos * 32 + j) * 2 + 1] = sinf(ang);
    } else {
      int jj = j - 32, f = jj & 63; float inv = powf(10000.f, -(float)f / 64.f); float ang = (jj < 64 ? row : col) * inv;
      p.cs256[(pos * 128 + jj) * 2] = cosf(ang); p.cs256[(pos * 128 + jj) * 2 + 1] = sinf(ang);
    }
  }
  const int t1 = (N1 / 64) * 32, t2 = 32 * 64;
  for (int it = b; it < t1 + t2; it += G_) {
    if (it < t1) tr_tile(p.ab_w_in, 16416, 2048, 1, nullptr, p.WA, it, tl);
    else tr_tile(p.ab_w_out, 2048, 4096, 0, nullptr, p.WO1, it - t1, tl);
  }
}
DI void phase_prep1(const Params& p, char* smem) {
  float* tl = (float*)smem;
  const int G_ = gridDim.x, b = blockIdx.x;
  const int t1 = (N2 / 64) * 32, t2 = 32 * 64, t3 = 48 * 8, t4 = 64 * 4;
  bfu* wa = p.WA;
  for (int it = b; it < t1 + t2 + t3 + t4; it += G_) {
    if (it < t1) tr_tile(p.cd_w_in, 11072, 2048, 2, nullptr, (bfu*)((char*)wa + WA_W2), it, tl);
    else if (it < t1 + t2) tr_tile(p.cd_w_out, 2048, 4096, 0, nullptr, (bfu*)((char*)wa + WA_WO2), it - t1, tl);
    else if (it < t1 + t2 + t3) tr_tile(p.w_uq, 3072, 512, 0, p.q_norm_g, (bfu*)((char*)wa + WA_UQ), it - t1 - t2, tl);
    else tr_tile(p.w_ukv, 4096, 256, 0, p.kv_norm_g, (bfu*)((char*)wa + WA_UKV), it - t1 - t2 - t3, tl);
  }
}

DI void phase_mod(const Params& p, int g, int layer, char* smem) {
  float* red = (float*)smem;
  const int tid = threadIdx.x, c0 = tid * 8;
  bfu* h = (bfu*)((char*)p.G + (layer == 0 ? L0_H : L1_H));
  for (int i = blockIdx.x; i < MG; i += gridDim.x) {
    long r = (long)g * MG + i; int b = (int)(r / T), t = (int)(r % T);
    float v[8];
    if (layer == 0) {
      const float* s = t < CTX ? p.ctx + ((long)b * CTX + t) * DM : p.x + ((long)b * SEQ + (t - CTX)) * DM;
      f32x4 a = *(const f32x4*)(s + c0), bb = *(const f32x4*)(s + c0 + 4);
      for (int j = 0; j < 4; ++j) { v[j] = a[j]; v[4 + j] = bb[j]; }
    } else {
      float* s = p.ZX + r * DM;
      f32x4 a = *(const f32x4*)(s + c0), bb = *(const f32x4*)(s + c0 + 4);
      for (int j = 0; j < 4; ++j) { v[j] = a[j]; v[4 + j] = bb[j]; }
      float sm = 0; for (int j = 0; j < 8; ++j) sm += v[j];
      float mean = block_sum(sm, red) * (1.f / DM);
      float sq = 0; for (int j = 0; j < 8; ++j) { v[j] -= mean; sq += v[j] * v[j]; }
      float rstd = rsqrtf(block_sum(sq, red) * (1.f / DM) + EPS);
      for (int j = 0; j < 8; ++j) v[j] = v[j] * rstd * p.ln_g[c0 + j] + p.ln_b[c0 + j];
      f32x4 o0 = {v[0], v[1], v[2], v[3]}, o1 = {v[4], v[5], v[6], v[7]};
      *(f32x4*)(s + c0) = o0; *(f32x4*)(s + c0 + 4) = o1;
    }
    const float* md = p.mod + ((long)layer * 9 + (t < CTX ? 8 : b)) * 6144;
    float o[8];
    for (int j = 0; j < 8; ++j) o[j] = v[j] * (1.f + md[2048 + c0 + j]) + md[c0 + j];
    st8(h + (long)i * DM + c0, pack8f(o));
  }
}
DI void phase_final(const Params& p, char* smem) {
  float* red = (float*)smem;
  const int tid = threadIdx.x, c0 = tid * 8;
  for (int i = blockIdx.x; i < NB * SEQ; i += gridDim.x) {
    int b = i / SEQ, pos = i % SEQ;
    const float* s = p.ZX + ((long)b * T + CTX + pos) * DM;
    float v[8];
    f32x4 a = *(const f32x4*)(s + c0), bb = *(const f32x4*)(s + c0 + 4);
    for (int j = 0; j < 4; ++j) { v[j] = a[j]; v[4 + j] = bb[j]; }
    float sm = 0; for (int j = 0; j < 8; ++j) sm += v[j];
    float mean = block_sum(sm, red) * (1.f / DM);
    float sq = 0; for (int j = 0; j < 8; ++j) { v[j] -= mean; sq += v[j] * v[j]; }
    float rstd = rsqrtf(block_sum(sq, red) * (1.f / DM) + EPS);
    for (int j = 0; j < 8; ++j) v[j] = v[j] * rstd * p.ln_g[DM + c0 + j] + p.ln_b[DM + c0 + j];
    f32x4 o0 = {v[0], v[1], v[2], v[3]}, o1 = {v[4], v[5], v[6], v[7]};
    float* d = p.out + (long)i * DM;
    *(f32x4*)(d + c0) = o0; *(f32x4*)(d + c0 + 4) = o1;
  }
}

DI void gemm_tile(const bfu* __restrict__ A, int lda, const bfu* __restrict__ Bt, int ldb, int K, char* smem) {
  const int tid = threadIdx.x, lane = tid & 63, w = tid >> 6, wm = w >> 1, wn = w & 1, l32 = lane & 31, hi = lane >> 5;
  bfu* As = (bfu*)smem; bfu* Bs = As + 2 * 128 * LDT;
  const int sr = tid >> 3, sc = (tid & 7) * 8;
  const bfu* Ag = A + (long)sr * lda + sc; const bfu* Bg = Bt + (long)sr * ldb + sc;
  bf16x8 ra[4], rb[4];
#pragma unroll
  for (int i = 0; i < 4; ++i) { ra[i] = ld8(Ag + (long)(32 * i) * lda); rb[i] = ld8(Bg + (long)(32 * i) * ldb); }
  f32x16 acc[2][2];
#pragma unroll
  for (int i = 0; i < 2; ++i)
#pragma unroll
    for (int j = 0; j < 2; ++j)
#pragma unroll
      for (int r = 0; r < 16; ++r) acc[i][j][r] = 0.f;
  __syncthreads();
#pragma unroll
  for (int i = 0; i < 4; ++i) { st8(As + (sr + 32 * i) * LDT + sc, ra[i]); st8(Bs + (sr + 32 * i) * LDT + sc, rb[i]); }
  __syncthreads();
  const int nk = K / BK;
  for (int kt = 0; kt < nk; ++kt) {
    const int cur = kt & 1;
    if (kt + 1 < nk) {
#pragma unroll
      for (int i = 0; i < 4; ++i) { ra[i] = ld8(Ag + (long)(32 * i) * lda + (kt + 1) * BK); rb[i] = ld8(Bg + (long)(32 * i) * ldb + (kt + 1) * BK); }
    }
    const bfu* as = As + cur * 128 * LDT + (wm * 64 + l32) * LDT + hi * 8;
    const bfu* bs = Bs + cur * 128 * LDT + (wn * 64 + l32) * LDT + hi * 8;
#pragma unroll
    for (int ks = 0; ks < 4; ++ks) {
      bf16x8 a0 = ld8(as + ks * 16), a1 = ld8(as + 32 * LDT + ks * 16), b0 = ld8(bs + ks * 16), b1 = ld8(bs + 32 * LDT + ks * 16);
      acc[0][0] = MFMA(a0, b0, acc[0][0]); acc[0][1] = MFMA(a0, b1, acc[0][1]);
      acc[1][0] = MFMA(a1, b0, acc[1][0]); acc[1][1] = MFMA(a1, b1, acc[1][1]);
    }
    if (kt + 1 < nk) {
      bfu* ad = As + (cur ^ 1) * 128 * LDT; bfu* bd = Bs + (cur ^ 1) * 128 * LDT;
#pragma unroll
      for (int i = 0; i < 4; ++i) { st8(ad + (sr + 32 * i) * LDT + sc, ra[i]); st8(bd + (sr + 32 * i) * LDT + sc, rb[i]); }
    }
    __syncthreads();
  }
  float* Cs = (float*)smem;
#pragma unroll
  for (int mi = 0; mi < 2; ++mi)
#pragma unroll
    for (int ni = 0; ni < 2; ++ni)
#pragma unroll
      for (int r = 0; r < 16; ++r) Cs[(wm * 64 + mi * 32 + crow(r, hi)) * CLD + wn * 64 + ni * 32 + l32] = acc[mi][ni][r];
  __syncthreads();
}
DI void ldrow8(const float* Cs, int row, int c, float* v) {
  f32x4 a = *(const f32x4*)(Cs + row * CLD + c), b = *(const f32x4*)(Cs + row * CLD + c + 4);
  for (int j = 0; j < 4; ++j) { v[j] = a[j]; v[4 + j] = b[j]; }
}
DI void store_R(const float* Cs, int cb, int nc, bfu* dst, long ld, float scale, const float* rs = nullptr) {
  const int cpr = nc >> 3;
  for (int u = threadIdx.x; u < 128 * cpr; u += NT) {
    int row = u / cpr, c8 = (u % cpr) * 8; float v[8]; ldrow8(Cs, row, cb + c8, v);
    float s = rs ? scale * rs[row] : scale;
    for (int j = 0; j < 8; ++j) v[j] *= s;
    st8(dst + row * ld + c8, pack8f(v));
  }
}
DI void store_T(const float* Cs, int cb, int nc, bfu* dst, long ldT, float scale, const float* rs = nullptr) {
  for (int u = threadIdx.x; u < nc * 16; u += NT) {
    int c = u >> 4, rc = (u & 15) * 8; float v[8];
    for (int j = 0; j < 8; ++j) v[j] = Cs[(rc + j) * CLD + cb + c] * (rs ? scale * rs[rc + j] : scale);
    st8(dst + c * ldT + rc, pack8f(v));
  }
}
DI void rope_inplace(float* Cs, int cb, int HALF, const float* cs, int tstride, int idx0, int pos0) {
  const int cpr = HALF >> 3;
  for (int u = threadIdx.x; u < 128 * cpr; u += NT) {
    int row = u / cpr, c8 = (u % cpr) * 8; float a[8], b[8];
    ldrow8(Cs, row, cb + c8, a); ldrow8(Cs, row, cb + HALF + c8, b);
    const float* t = cs + (long)(pos0 + row) * tstride + (idx0 + c8) * 2;
    for (int j = 0; j < 8; ++j) { float co = t[2 * j], si = t[2 * j + 1]; float x1 = a[j], x2 = b[j]; a[j] = x1 * co - x2 * si; b[j] = x1 * si + x2 * co; }
    f32x4 o;
    o = (f32x4){a[0], a[1], a[2], a[3]}; *(f32x4*)(Cs + row * CLD + cb + c8) = o;
    o = (f32x4){a[4], a[5], a[6], a[7]}; *(f32x4*)(Cs + row * CLD + cb + c8 + 4) = o;
    o = (f32x4){b[0], b[1], b[2], b[3]}; *(f32x4*)(Cs + row * CLD + cb + HALF + c8) = o;
    o = (f32x4){b[4], b[5], b[6], b[7]}; *(f32x4*)(Cs + row * CLD + cb + HALF + c8 + 4) = o;
  }
  __syncthreads();
}

DI void epi_in0(const Params& p, float* Cs, int m0, int n0) {
  char* G = (char*)p.G;
  const int bg = m0 / T, t0 = m0 % T; const bool lat = t0 >= CTX;
  if (n0 < 4096) {
    const bool isq = n0 < 2048; const int head = (n0 & 2047) >> 7;
    if (lat) { rope_inplace(Cs, 0, 32, p.cs64, 64, 0, t0 - CTX); rope_inplace(Cs, 64, 32, p.cs64, 64, 0, t0 - CTX); }
    bfu* dst = (bfu*)(G + (isq ? L0_QD : L0_KD));
    for (int m = 0; m < 2; ++m) store_R(Cs, m * 64, 64, dst + ((long)(bg * 32 + head * 2 + m) * T + t0) * 64, 64, isq ? 0.125f : 1.f);
  } else if (n0 < 6144) {
    const int head = (n0 - 4096) >> 7;
    store_T(Cs, 0, 128, (bfu*)(G + L0_VT) + ((long)(bg * 16 + head) * 128) * T + t0, T, 1.f);
  } else if (n0 < 7168) {
    const int head = (n0 - 6144) >> 7;
    store_R(Cs, 0, 128, (bfu*)(G + L0_MQ) + ((long)(bg * 8 + head) * T + t0) * 128, 128, 0.08838834764831845f);
  } else if (n0 < 8192) {
    const int head = (n0 - 7168) >> 7;
    store_R(Cs, 0, 128, (bfu*)(G + L0_MK) + ((long)(bg * 8 + head) * T + t0) * 128, 128, 1.f);
    store_T(Cs, 0, 128, (bfu*)(G + L0_MKT) + ((long)(bg * 8 + head) * 128) * T + t0, T, 1.f);
  } else if (n0 < 10240) {
    const int head = (n0 - 8192) >> 8, d0 = (n0 - 8192) & 255;
    store_T(Cs, 0, 128, (bfu*)(G + L0_MVT) + ((long)(bg * 8 + head) * 256 + d0) * T + t0, T, 1.f);
  } else if (n0 < 12288) {
    store_R(Cs, 0, 128, (bfu*)(G + L0_OG) + (long)m0 * 2048 + (n0 - 10240), 2048, 1.f);
  } else if (n0 < 16384) {
    store_R(Cs, 0, 128, (bfu*)(G + L0_GATE) + (long)m0 * 4096 + (n0 - 12288), 4096, 1.f);
  } else {
    float* gi = (float*)(G + L0_SM + SM_GI); float* gf = (float*)(G + L0_SM + SM_GF);
    for (int u = threadIdx.x; u < 128 * 32; u += NT) {
      int row = u >> 5, c = u & 31; float v = Cs[row * CLD + c];
      int cc = c & 15, dir = cc >> 3, head = cc & 7; long o = ((long)(dir * GB + bg) * 8 + head) * T + t0 + row;
      if (c < 16) gi[o] = v + p.ab_b_if[dir * 8 + head];
      else gf[o] = logsig(v + p.ab_b_if[16 + dir * 8 + head]);
    }
  }
}
DI void epi_in1(const Params& p, float* Cs, int m0, int n0) {
  char* G = (char*)p.G;
  const int bg = m0 / T, t0 = m0 % T; const bool lat = t0 >= CTX;
  if (n0 < 4096) {
    const bool isq = n0 < 2048; const int head = (n0 & 2047) >> 8, par = (n0 >> 7) & 1;
    if (lat) rope_inplace(Cs, 0, 64, p.cs256, 256, par * 64, t0 - CTX);
    bfu* dst = (bfu*)(G + (isq ? L1_RQ : L1_RK)) + ((long)(bg * 8 + head) * T + t0) * 256;
    const float sc = isq ? 1.f : 0.0625f;
    store_R(Cs, 0, 64, dst + par * 64, 256, sc); store_R(Cs, 64, 64, dst + 128 + par * 64, 256, sc);
    if (!isq) {
      bfu* dT = (bfu*)(G + L1_RKT) + ((long)(bg * 8 + head) * 256) * T + t0;
      store_T(Cs, 0, 64, dT + (long)(par * 64) * T, T, sc); store_T(Cs, 64, 64, dT + (long)(128 + par * 64) * T, T, sc);
    }
  } else if (n0 < 6144) {
    const int head = (n0 - 4096) >> 8, d0 = (n0 - 4096) & 255;
    store_T(Cs, 0, 128, (bfu*)(G + L1_RVT) + ((long)(bg * 8 + head) * 256 + d0) * T + t0, T, 1.f);
  } else if (n0 < 6912) {
    const bool isq = n0 < 6656; const int j = isq ? (n0 - 6144) >> 7 : (n0 - 6656) >> 7;
    if (isq) store_R(Cs, 0, 128, (bfu*)(G + L1_QL) + (long)m0 * 512 + j * 128, 512, 1.f);
    else store_R(Cs, 0, 128, (bfu*)(G + L1_KVL) + (long)m0 * 256 + j * 128, 256, 1.f);
    float* ss = (float*)(G + L1_SM + (isq ? SM_SSQ : SM_SSK));
    for (int u = threadIdx.x; u < 2048; u += NT) {
      int row = u >> 4, c8 = (u & 15) * 8; float v[8]; ldrow8(Cs, row, c8, v);
      float s = 0; for (int jj = 0; jj < 8; ++jj) s += v[jj] * v[jj];
      s += __shfl_xor(s, 1); s += __shfl_xor(s, 2); s += __shfl_xor(s, 4); s += __shfl_xor(s, 8);
      if ((u & 15) == 0) ss[(long)(m0 + row) * (isq ? 4 : 2) + j] = s;
    }
  } else if (n0 < 7040) {
    if (lat) rope_inplace(Cs, 0, 32, p.cs64, 64, 0, t0 - CTX);
    for (int hh = 0; hh < 16; ++hh) store_R(Cs, 0, 64, (bfu*)(G + L1_K) + ((long)(bg * 16 + hh) * T + t0) * 192 + 128, 192, 1.f);
  } else {
    store_R(Cs, 0, 128, (bfu*)(G + L1_GATE) + (long)m0 * 4096 + (n0 - 7040), 4096, 1.f);
  }
}
DI void epi_uq(const Params& p, float* Cs, int m0, int n0, const float* rsl) {
  char* G = (char*)p.G;
  const int bg = m0 / T, t0 = m0 % T; const bool lat = t0 >= CTX;
  for (int gq = 0; gq < 2; ++gq) {
    int gi = (n0 >> 6) + gq, head = gi / 3, part = gi % 3;
    if (part == 2 && lat) rope_inplace(Cs, gq * 64, 32, p.cs64, 64, 0, t0 - CTX);
    store_R(Cs, gq * 64, 64, (bfu*)(G + L1_Q) + ((long)(bg * 16 + head) * T + t0) * 192 + part * 64, 192, 0.07216878364870323f, rsl);
  }
}
DI void epi_ukv(const Params& p, float* Cs, int m0, int n0, const float* rsl) {
  char* G = (char*)p.G;
  const int bg = m0 / T, t0 = m0 % T; const int head = n0 >> 8;
  if ((n0 & 255) == 0) store_R(Cs, 0, 128, (bfu*)(G + L1_K) + ((long)(bg * 16 + head) * T + t0) * 192, 192, 1.f, rsl);
  else store_T(Cs, 0, 128, (bfu*)(G + L1_VT) + ((long)(bg * 16 + head) * 128) * T + t0, T, 1.f, rsl);
}
DI void epi_out(const Params& p, const float* Cs, int g, int layer, int m0, int n0) {
  for (int u = threadIdx.x; u < 2048; u += NT) {
    int row = u >> 4, c8 = (u & 15) * 8; float v[8]; ldrow8(Cs, row, c8, v);
    long r = (long)g * MG + m0 + row; int b = (int)(r / T), t = (int)(r % T);
    float* z = p.ZX + r * DM + n0 + c8;
    const float* xs = layer == 0 ? (t < CTX ? p.ctx + ((long)b * CTX + t) * DM : p.x + ((long)b * SEQ + (t - CTX)) * DM) + n0 + c8 : z;
    const float* gt = p.mod + ((long)layer * 9 + (t < CTX ? 8 : b)) * 6144 + 4096 + n0 + c8;
    f32x4 x0 = *(const f32x4*)xs, x1 = *(const f32x4*)(xs + 4), o0, o1;
    for (int j = 0; j < 4; ++j) { o0[j] = ALPHA * x0[j] + gt[j] * v[j]; o1[j] = ALPHA * x1[j] + gt[4 + j] * v[4 + j]; }
    *(f32x4*)z = o0; *(f32x4*)(z + 4) = o1;
  }
}

DI void phase_gemm(const Params& p, int g, int kind, char* smem, float* rsl) {
  char* G = (char*)p.G; float* Cs = (float*)smem;
  const int MT = MG / 128;
  int ntn;
  if (kind == 0) ntn = N1 / 128; else if (kind == 1) ntn = N2 / 128; else if (kind == 2) ntn = 24 + 32; else ntn = 16;
  const int total = MT * ntn;
  for (int tile = blockIdx.x; tile < total; tile += gridDim.x) {
    const int nt = tile / MT, mt = tile % MT, m0 = mt * 128;
    const bfu* A; const bfu* Bt; int K; int n0 = nt * 128;
    if (kind == 0) { A = (const bfu*)(G + L0_H) + (long)m0 * 2048; Bt = p.WA + (long)n0 * 2048; K = 2048; }
    else if (kind == 1) { A = (const bfu*)(G + L1_H) + (long)m0 * 2048; Bt = (const bfu*)((char*)p.WA + WA_W2) + (long)n0 * 2048; K = 2048; }
    else if (kind == 2) {
      const bool uq = nt < 24;
      __syncthreads();
      if (threadIdx.x < 128) {
        float s;
        if (uq) { const float* q = (const float*)(G + L1_SM + SM_SSQ) + (long)(m0 + threadIdx.x) * 4; s = (q[0] + q[1] + q[2] + q[3]) * (1.f / 512.f); }
        else { const float* q = (const float*)(G + L1_SM + SM_SSK) + (long)(m0 + threadIdx.x) * 2; s = (q[0] + q[1]) * (1.f / 256.f); }
        rsl[threadIdx.x] = rsqrtf(s + EPS);
      }
      if (uq) { A = (const bfu*)(G + L1_QL) + (long)m0 * 512; Bt = (const bfu*)((char*)p.WA + WA_UQ) + (long)n0 * 512; K = 512; }
      else { n0 -= 24 * 128; A = (const bfu*)(G + L1_KVL) + (long)m0 * 256; Bt = (const bfu*)((char*)p.WA + WA_UKV) + (long)n0 * 256; K = 256; }
    } else {
      const int layer = kind - 3;
      if (layer == 1 && (m0 % T) < CTX) continue;
      A = (const bfu*)(G + (layer == 0 ? L0_MIX : L1_MIX)) + (long)m0 * 4096;
      Bt = (layer == 0 ? p.WO1 : (const bfu*)((char*)p.WA + WA_WO2)) + (long)n0 * 4096; K = 4096;
    }
    gemm_tile(A, K, Bt, K, K, smem);
    if (kind == 0) epi_in0(p, Cs, m0, n0);
    else if (kind == 1) epi_in1(p, Cs, m0, n0);
    else if (kind == 2) { if (nt < 24) epi_uq(p, Cs, m0, n0, rsl); else epi_ukv(p, Cs, m0, n0, rsl); }
    else epi_out(p, Cs, g, kind - 3, m0, n0);
  }
}

template <int DK>
DI void attn_item(const bfu* __restrict__ Qp, const bfu* __restrict__ Kp, const bfu* __restrict__ Vtp, int nkeys, bfu* __restrict__ Op, int ldo, char* smem) {
  constexpr int LK = DK + 8, LV = 72, NKS = DK / 16, KCH = DK / 32, CPR = DK / 8;
  bfu* Ks = (bfu*)smem; bfu* Vs = Ks + 64 * LK;
  const int tid = threadIdx.x, lane = tid & 63, w = tid >> 6, l32 = lane & 31, hi = lane >> 5;
  bf16x8 qf[NKS];
  {
    const bfu* qrow = Qp + (long)(w * 32 + l32) * DK + hi * 8;
#pragma unroll
    for (int ks = 0; ks < NKS; ++ks) qf[ks] = ld8(qrow + ks * 16);
  }
  f32x16 o[4];
#pragma unroll
  for (int d = 0; d < 4; ++d)
#pragma unroll
    for (int r = 0; r < 16; ++r) o[d][r] = 0.f;
  float m = -1e30f, lsum = 0.f;
  bf16x8 kr[KCH], vr[4];
#define ATT_LOAD(key0)                                                                                   \
  do {                                                                                                   \
    _Pragma("unroll") for (int i = 0; i < KCH; ++i) { int c = tid + NT * i; kr[i] = ld8(Kp + (long)((key0) + c / CPR) * DK + (c % CPR) * 8); } \
    _Pragma("unroll") for (int i = 0; i < 4; ++i) { int c = tid + NT * i; vr[i] = ld8(Vtp + (long)(c >> 3) * T + (key0) + (c & 7) * 8); }    \
  } while (0)
  ATT_LOAD(0);
  const int NTL = nkeys >> 6;
  for (int j = 0; j < NTL; ++j) {
    __syncthreads();
#pragma unroll
    for (int i = 0; i < KCH; ++i) { int c = tid + NT * i; st8(Ks + (c / CPR) * LK + (c % CPR) * 8, kr[i]); }
#pragma unroll
    for (int i = 0; i < 4; ++i) { int c = tid + NT * i; st8(Vs + (c >> 3) * LV + (c & 7) * 8, vr[i]); }
    __syncthreads();
    if (j + 1 < NTL) ATT_LOAD((j + 1) * 64);
    f32x16 s0, s1;
#pragma unroll
    for (int r = 0; r < 16; ++r) { s0[r] = 0.f; s1[r] = 0.f; }
    const bfu* k0p = Ks + l32 * LK + hi * 8;
#pragma unroll
    for (int ks = 0; ks < NKS; ++ks) {
      bf16x8 a0 = ld8(k0p + ks * 16), a1 = ld8(k0p + 32 * LK + ks * 16);
      s0 = MFMA(a0, qf[ks], s0); s1 = MFMA(a1, qf[ks], s1);
    }
    float mx = s0[0];
#pragma unroll
    for (int r = 0; r < 16; ++r) mx = fmaxf(mx, fmaxf(s0[r], s1[r]));
    mx = fmaxf(mx, __shfl_xor(mx, 32));
    const float mn = fmaxf(m, mx), alpha = __builtin_amdgcn_exp2f((m - mn) * LOG2E), mnl = mn * LOG2E;
    m = mn;
    float rs = 0.f;
#pragma unroll
    for (int r = 0; r < 16; ++r) { s0[r] = __builtin_amdgcn_exp2f(s0[r] * LOG2E - mnl); s1[r] = __builtin_amdgcn_exp2f(s1[r] * LOG2E - mnl); rs += s0[r] + s1[r]; }
    lsum = lsum * alpha + rs;
#pragma unroll
    for (int d = 0; d < 4; ++d)
#pragma unroll
      for (int r = 0; r < 16; ++r) o[d][r] *= alpha;
    bf16x8 pf[4] = {packacc(s0, 0), packacc(s0, 1), packacc(s1, 0), packacc(s1, 1)};
#pragma unroll
    for (int kk = 0; kk < 4; ++kk)
#pragma unroll
      for (int d = 0; d < 4; ++d) {
        bf16x8 a = ld44(Vs + (d * 32 + l32) * LV + kk * 16 + 4 * hi);
        o[d] = MFMA(a, pf[kk], o[d]);
      }
  }
#undef ATT_LOAD
  const float inv = 1.f / (lsum + __shfl_xor(lsum, 32));
  bfu* orow = Op + (long)(w * 32 + l32) * ldo;
#pragma unroll
  for (int d = 0; d < 4; ++d)
#pragma unroll
    for (int rg = 0; rg < 4; ++rg) {
      u32x2 v = {cvtpk(o[d][4 * rg] * inv, o[d][4 * rg + 1] * inv), cvtpk(o[d][4 * rg + 2] * inv, o[d][4 * rg + 3] * inv)};
      *reinterpret_cast<u32x2*>(orow + d * 32 + 8 * rg + 4 * hi) = v;
    }
}

template <bool ML>
DI void scan_wave(const Params& p, int witem, float* wsm) {
  constexpr int DKS = ML ? 128 : 256, NTI = DKS / 32, NDV = ML ? 9 : 8;
  char* G = (char*)p.G;
  const int lane = threadIdx.x & 63, l32 = lane & 31, hi = lane >> 5;
  const int dvb = witem % NDV; int rest = witem / NDV; const int dir = rest & 1; rest >>= 1; const int head = rest & 7; const int bg = rest >> 3;
  const bool isden = ML && dvb == 8;
  const long hb = (long)(bg * 8 + head);
  const bfu* q = (const bfu*)(G + (ML ? L0_MQ : L1_RQ)) + hb * T * DKS;
  const bfu* k = (const bfu*)(G + (ML ? L0_MK : L1_RK)) + hb * T * DKS;
  const bfu* kT = (const bfu*)(G + (ML ? L0_MKT : L1_RKT)) + hb * DKS * T;
  const bfu* vT = (const bfu*)(G + (ML ? L0_MVT : L1_RVT)) + (hb * 256 + (isden ? 0 : dvb) * 32) * T;
  const float* gip = (const float*)(G + L0_SM + SM_GI) + ((long)(dir * GB + bg) * 8 + head) * T;
  const float* gfp = (const float*)(G + L0_SM + SM_GF) + ((long)(dir * GB + bg) * 8 + head) * T;
  float* dnp = (float*)(G + L0_SM + SM_DN) + ((long)(dir * GB + bg) * 8 + head) * T;
  bfu* outp = (bfu*)(G + (ML ? L0_HN : L1_R)) + ((long)dir * MG + (long)bg * T) * 2048 + head * 256 + dvb * 32;
  float lg2 = 0.f;
  if (!ML) lg2 = logsig(p.ret_decay[dir * 8 + head]) * LOG2E;
  const bf16x8 ones = {0x3F80, 0x3F80, 0x3F80, 0x3F80, 0x3F80, 0x3F80, 0x3F80, 0x3F80};
  f32x16 C[NTI];
#pragma unroll
  for (int i = 0; i < NTI; ++i)
#pragma unroll
    for (int r = 0; r < 16; ++r) C[i][r] = 0.f;
  float mst = 0.f;
  for (int ci = 0; ci < 36; ++ci) {
    const int chunk = dir == 0 ? ci : (ci < 4 ? 3 - ci : 39 - ci);
    const int p0 = chunk * 64;
    float decay = 1.f;
    if (ML) {
      float f = gfp[p0 + lane], ig = gip[p0 + lane];
      float b = f;
      for (int off = 1; off < 64; off <<= 1) {
        float y = dir == 0 ? __shfl_up(b, off) : __shfl_down(b, off);
        bool ok = dir == 0 ? lane >= off : lane + off < 64;
        if (ok) b += y;
      }
      const float gs = ig - b;
      float cm = gs;
      for (int off = 1; off < 64; off <<= 1) {
        float y = dir == 0 ? __shfl_up(cm, off) : __shfl_down(cm, off);
        bool ok = dir == 0 ? lane >= off : lane + off < 64;
        if (ok) cm = fmaxf(cm, y);
      }
      const float bend = __shfl(b, dir == 0 ? 63 : 0);
      const float inter = b + mst, mt = fmaxf(b + cm, inter), a = __expf(inter - mt);
      const float gmax = bend + wmax(gs);
      const float mnew = fmaxf(bend + mst, gmax);
      decay = __expf(bend + mst - mnew);
      const float wk = __expf(bend + gs - mnew);
      __builtin_amdgcn_wave_barrier();
      wsm[lane] = b - mt; wsm[64 + lane] = gs; wsm[128 + lane] = a; wsm[192 + lane] = wk; wsm[256 + lane] = __expf(-mt);
      __builtin_amdgcn_wave_barrier();
      mst = mnew;
    } else {
      decay = __builtin_amdgcn_exp2f(lg2 * 64.f);
    }
#pragma unroll 1
    for (int tb = 0; tb < 2; ++tb) {
      const int tl = tb * 32 + l32;
      const long trow = p0 + tl;
      f32x16 sc[2];
#pragma unroll
      for (int sb = 0; sb < 2; ++sb) {
#pragma unroll
        for (int r = 0; r < 16; ++r) sc[sb][r] = 0.f;
        const bool need = dir == 0 ? (sb <= tb) : (sb >= tb);
        if (need) {
          const bfu* kp = k + (long)(p0 + sb * 32 + l32) * DKS + hi * 8;
          const bfu* qp = q + trow * DKS + hi * 8;
#pragma unroll 2
          for (int ks = 0; ks < DKS / 16; ++ks) sc[sb] = MFMA(ld8(kp + ks * 16), ld8(qp + ks * 16), sc[sb]);
          __builtin_amdgcn_sched_barrier(0);
          float sBt = 0.f;
          if (ML) sBt = wsm[tl];
#pragma unroll
          for (int r = 0; r < 16; ++r) {
            const int s = sb * 32 + crow(r, hi);
            const bool valid = dir == 0 ? s <= tl : s >= tl;
            float wgt;
            if (ML) wgt = __expf(sBt + wsm[64 + s]);
            else wgt = __builtin_amdgcn_exp2f(lg2 * (float)(tl > s ? tl - s : s - tl));
            sc[sb][r] = valid ? sc[sb][r] * wgt : 0.f;
          }
        }
      }
      f32x16 out;
#pragma unroll
      for (int r = 0; r < 16; ++r) out[r] = 0.f;
      __builtin_amdgcn_sched_barrier(0);
      {
        const bfu* qp2 = q + trow * DKS + 4 * hi;
#pragma unroll
        for (int i = 0; i < NTI; ++i)
#pragma unroll
          for (int s2 = 0; s2 < 2; ++s2) { out = MFMA(packacc(C[i], s2), ld44(qp2 + 32 * i + 16 * s2), out); if ((i & 1) && s2) __builtin_amdgcn_sched_barrier(0); }
      }
      float sct;
      if (ML) sct = wsm[128 + tl];
      else sct = __builtin_amdgcn_exp2f(lg2 * (dir == 0 ? (float)(tl + 1) : (float)(64 - tl)));
#pragma unroll
      for (int r = 0; r < 16; ++r) out[r] *= sct;
#pragma unroll
      for (int sb = 0; sb < 2; ++sb) {
        const bool need = dir == 0 ? (sb <= tb) : (sb >= tb);
        if (need) {
#pragma unroll
          for (int s2 = 0; s2 < 2; ++s2) {
            bf16x8 a = ones;
            if (!isden) a = ld44(vT + (long)l32 * T + p0 + sb * 32 + 16 * s2 + 4 * hi);
            out = MFMA(a, packacc(sc[sb], s2), out);
          }
        }
      }
      if (!isden) {
        bfu* orow = outp + trow * 2048;
#pragma unroll
        for (int rg = 0; rg < 4; ++rg) {
          u32x2 v = {cvtpk(out[4 * rg], out[4 * rg + 1]), cvtpk(out[4 * rg + 2], out[4 * rg + 3])};
          *reinterpret_cast<u32x2*>(orow + 8 * rg + 4 * hi) = v;
        }
      } else if (hi == 0) {
        dnp[trow] = fmaxf(fabsf(out[0]), wsm[256 + tl]);
      }
    }
    __builtin_amdgcn_sched_barrier(0);
#pragma unroll
    for (int i = 0; i < NTI; ++i)
#pragma unroll
      for (int r = 0; r < 16; ++r) C[i][r] *= decay;
#pragma unroll 1
    for (int s4 = 0; s4 < 4; ++s4) {
      float vf[8];
      if (isden) { for (int j = 0; j < 8; ++j) vf[j] = 1.f; }
      else unpack8(ld8(vT + (long)l32 * T + p0 + s4 * 16 + hi * 8), vf);
#pragma unroll
      for (int j = 0; j < 8; ++j) {
        const int s = s4 * 16 + hi * 8 + j;
        float wgt;
        if (ML) wgt = wsm[192 + s];
        else wgt = __builtin_amdgcn_exp2f(lg2 * (dir == 0 ? (float)(63 - s) : (float)s));
        vf[j] *= wgt;
      }
      const bf16x8 bfr = pack8f(vf);
#pragma unroll
      for (int i = 0; i < NTI; ++i) C[i] = MFMA(ld8(kT + (long)(32 * i + l32) * T + p0 + s4 * 16 + hi * 8), bfr, C[i]);
    }
  }
}

template <int layer>
DI void phase_mix(const Params& p, int cidx, char* smem, int* s_item) {
  char* G = (char*)p.G;
  const int tid = threadIdx.x, w = tid >> 6;
  const int nscan = layer == 0 ? (GB * 8 * 2 * 9) / 4 : (GB * 8 * 2 * 8) / 4;
  const int natt = layer == 0 ? GB * 32 * 16 + GB * 32 * 2 : GB * 16 * 16;
  for (;;) {
    __syncthreads();
    if (tid == 0) *s_item = atomicAdd(p.ctr + cidx, 1);
    __syncthreads();
    const int item = *s_item;
    if (item >= nscan + natt) break;
    if (item < nscan) {
      float* wsm = (float*)smem + w * 320;
      if (layer == 0) scan_wave<true>(p, item * 4 + w, wsm);
      else scan_wave<false>(p, item * 4 + w, wsm);
    } else {
      int a = item - nscan;
      if (layer == 0) {
        int bg, hv, t0, nkeys;
        if (a < GB * 32 * 16) { bg = a / 512; hv = (a >> 4) & 31; t0 = CTX + (a & 15) * 128; nkeys = T; }
        else { a -= GB * 32 * 16; bg = a / 64; hv = (a >> 1) & 31; t0 = (a & 1) * 128; nkeys = CTX; }
        attn_item<64>((const bfu*)(G + L0_QD) + ((long)(bg * 32 + hv) * T + t0) * 64, (const bfu*)(G + L0_KD) + (long)(bg * 32 + hv) * T * 64,
                      (const bfu*)(G + L0_VT) + (long)(bg * 16 + (hv >> 1)) * 128 * T, nkeys, (bfu*)(G + L0_OA) + ((long)bg * T + t0) * 4096 + hv * 128, 4096, smem);
      } else {
        int bg = a / 256, h = (a >> 4) & 15, t0 = CTX + (a & 15) * 128;
        attn_item<192>((const bfu*)(G + L1_Q) + ((long)(bg * 16 + h) * T + t0) * 192, (const bfu*)(G + L1_K) + (long)(bg * 16 + h) * T * 192,
                       (const bfu*)(G + L1_VT) + (long)(bg * 16 + h) * 128 * T, T, (bfu*)(G + L1_OA) + ((long)bg * T + t0) * 2048 + h * 128, 2048, smem);
      }
    }
  }
}

DI void phase_comb0(const Params& p, char* smem) {
  char* G = (char*)p.G;
  const int tid = threadIdx.x, c0 = tid * 8;
  float* sl = (float*)smem;
  __syncthreads();
  if (tid < 64) {
    float a = wsum(p.diff_lam[tid] * p.diff_lam[64 + tid]), b = wsum(p.diff_lam[128 + tid] * p.diff_lam[192 + tid]);
    if (tid == 0) sl[0] = __expf(a) - __expf(b) + 0.2f;
  }
  __syncthreads();
  const float lam = sl[0];
  const bfu* Oa = (const bfu*)(G + L0_OA); const bfu* Hn = (const bfu*)(G + L0_HN); const bfu* og = (const bfu*)(G + L0_OG);
  const bfu* gate = (const bfu*)(G + L0_GATE); const float* dn = (const float*)(G + L0_SM + SM_DN); bfu* mix = (bfu*)(G + L0_MIX);
  for (int i = blockIdx.x; i < MG; i += gridDim.x) {
    const int bg = i / T, t = i % T;
    float o[8];
    {
      const int head = c0 >> 7, d = c0 & 127;
      float o1[8], o2[8], gt[8];
      unpack8(ld8(Oa + (long)i * 4096 + (head * 2) * 128 + d), o1); unpack8(ld8(Oa + (long)i * 4096 + (head * 2 + 1) * 128 + d), o2);
      unpack8(ld8(gate + (long)i * 4096 + c0), gt);
      float ss = 0;
      for (int j = 0; j < 8; ++j) { o1[j] -= lam * o2[j]; ss += o1[j] * o1[j]; }
      ss += __shfl_xor(ss, 1); ss += __shfl_xor(ss, 2); ss += __shfl_xor(ss, 4); ss += __shfl_xor(ss, 8);
      const float rms = rsqrtf(ss * (1.f / 128.f) + EPS) * 0.8f;
      for (int j = 0; j < 8; ++j) o[j] = o1[j] * rms * p.diff_g[c0 + j] * silu(gt[j]);
      st8(mix + (long)i * 4096 + c0, pack8f(o));
    }
    {
      const int head = c0 >> 8;
      float h0[8], h1[8], gt[8], ov[8];
      unpack8(ld8(Hn + (long)i * 2048 + c0), h0); unpack8(ld8(Hn + ((long)MG + i) * 2048 + c0), h1);
      unpack8(ld8(gate + (long)i * 4096 + 2048 + c0), gt); unpack8(ld8(og + (long)i * 2048 + c0), ov);
      const float d0 = 1.f / dn[((long)(0 * GB + bg) * 8 + head) * T + t], d1 = 1.f / dn[((long)(1 * GB + bg) * 8 + head) * T + t];
      float sm = 0;
      for (int j = 0; j < 8; ++j) { h0[j] = h0[j] * d0 + h1[j] * d1; sm += h0[j]; }
      sm += __shfl_xor(sm, 1); sm += __shfl_xor(sm, 2); sm += __shfl_xor(sm, 4); sm += __shfl_xor(sm, 8); sm += __shfl_xor(sm, 16);
      const float mean = sm * (1.f / 256.f);
      float sq = 0;
      for (int j = 0; j < 8; ++j) { h0[j] -= mean; sq += h0[j] * h0[j]; }
      sq += __shfl_xor(sq, 1); sq += __shfl_xor(sq, 2); sq += __shfl_xor(sq, 4); sq += __shfl_xor(sq, 8); sq += __shfl_xor(sq, 16);
      const float rstd = rsqrtf(sq * (1.f / 256.f) + EPS);
      for (int j = 0; j < 8; ++j) o[j] = h0[j] * rstd * p.mlstm_g[c0 + j] * sigm(ov[j]) * silu(gt[j]);
      st8(mix + (long)i * 4096 + 2048 + c0, pack8f(o));
    }
  }
}
DI void phase_comb1(const Params& p) {
  char* G = (char*)p.G;
  const int tid = threadIdx.x, c0 = tid * 8;
  const bfu* Oa = (const bfu*)(G + L1_OA); const bfu* R = (const bfu*)(G + L1_R); const bfu* gate = (const bfu*)(G + L1_GATE); bfu* mix = (bfu*)(G + L1_MIX);
  for (int i = blockIdx.x; i < MG; i += gridDim.x) {
    if ((i % T) < CTX) continue;
    float o[8];
    {
      float h0[8], h1[8], gt[8];
      unpack8(ld8(R + (long)i * 2048 + c0), h0); unpack8(ld8(R + ((long)MG + i) * 2048 + c0), h1); unpack8(ld8(gate + (long)i * 4096 + c0), gt);
      float sm = 0;
      for (int j = 0; j < 8; ++j) { h0[j] += h1[j]; sm += h0[j]; }
      sm += __shfl_xor(sm, 1); sm += __shfl_xor(sm, 2); sm += __shfl_xor(sm, 4); sm += __shfl_xor(sm, 8); sm += __shfl_xor(sm, 16);
      const float mean = sm * (1.f / 256.f);
      float sq = 0;
      for (int j = 0; j < 8; ++j) { h0[j] -= mean; sq += h0[j] * h0[j]; }
      sq += __shfl_xor(sq, 1); sq += __shfl_xor(sq, 2); sq += __shfl_xor(sq, 4); sq += __shfl_xor(sq, 8); sq += __shfl_xor(sq, 16);
      const float rstd = rsqrtf(sq * (1.f / 256.f) + EPS);
      for (int j = 0; j < 8; ++j) o[j] = h0[j] * rstd * p.ret_g[c0 + j] * silu(gt[j]);
      st8(mix + (long)i * 4096 + c0, pack8f(o));
    }
    {
      float a[8], gt[8];
      unpack8(ld8(Oa + (long)i * 2048 + c0), a); unpack8(ld8(gate + (long)i * 4096 + 2048 + c0), gt);
      for (int j = 0; j < 8; ++j) o[j] = a[j] * silu(gt[j]);
      st8(mix + (long)i * 4096 + 2048 + c0, pack8f(o));
    }
  }
}

template <int OP, int LAYER>
__global__ void __launch_bounds__(NT) phase_kernel(Params p, int g) {
  __shared__ __attribute__((aligned(16))) char smem[SMEM_BYTES];
  __shared__ float rsl[128];
  __shared__ int s_item;
  if (OP == 0) phase_prep0(p, smem);
  else if (OP == 1) phase_mod(p, g, LAYER, smem);
  else if (OP == 2) phase_gemm(p, g, LAYER, smem, rsl);
  else if (OP == 3) phase_gemm(p, g, 2, smem, rsl);
  else if (OP == 4) phase_mix<LAYER>(p, LAYER * 8 + g, smem, &s_item);
  else if (OP == 5) { if (LAYER == 0) phase_comb0(p, smem); else phase_comb1(p); }
  else if (OP == 6) phase_gemm(p, g, 3 + LAYER, smem, rsl);
  else if (OP == 7) phase_prep1(p, smem);
  else phase_final(p, smem);
}

#if !MULTI
__global__ void __launch_bounds__(NT) mega(Params p) {
  __shared__ __attribute__((aligned(16))) char smem[SMEM_BYTES];
  __shared__ float rsl[128];
  __shared__ int s_item;
  cg::grid_group grid = cg::this_grid();
  for (int ph = 0; ph < 2 + NG * 5 + NG * 6; ++ph) {
    int op, g = 0, layer = 0;
    if (ph == 0) op = 0;
    else if (ph <= NG * 5) { int q = ph - 1; g = q / 5; op = 1 + q % 5; if (op >= 3) op += 1; }
    else if (ph == NG * 5 + 1) op = 7;
    else { int q = ph - NG * 5 - 2; g = q / 6; op = 1 + q % 6; layer = 1; }
    Params q = p;
#define LAUNDER(f) asm volatile("" : "+s"(q.f))
    LAUNDER(x); LAUNDER(c); LAUNDER(ctx); LAUNDER(c_ctx); LAUNDER(ada_w); LAUNDER(ada_b); LAUNDER(ln_g); LAUNDER(ln_b); LAUNDER(ab_w_in); LAUNDER(ab_b_if);
    LAUNDER(diff_lam); LAUNDER(diff_g); LAUNDER(mlstm_g); LAUNDER(ab_w_out); LAUNDER(cd_w_in); LAUNDER(ret_decay); LAUNDER(ret_g); LAUNDER(q_norm_g);
    LAUNDER(w_uq); LAUNDER(kv_norm_g); LAUNDER(w_ukv); LAUNDER(cd_w_out); LAUNDER(out); LAUNDER(ZX); LAUNDER(WA); LAUNDER(WO1); LAUNDER(mod);
    LAUNDER(cs64); LAUNDER(cs256); LAUNDER(ctr); LAUNDER(G);
#undef LAUNDER
    switch (op) {
      case 0: phase_prep0(q, smem); break;
      case 1: phase_mod(q, g, layer, smem); break;
      case 2: phase_gemm(q, g, layer, smem, rsl); break;
      case 3: phase_gemm(q, g, 2, smem, rsl); break;
      case 4: if (layer == 0) phase_mix<0>(q, g, smem, &s_item); else phase_mix<1>(q, 8 + g, smem, &s_item); break;
      case 5: if (layer == 0) phase_comb0(q, smem); else phase_comb1(q); break;
      case 6: phase_gemm(q, g, 3 + layer, smem, rsl); break;
      default: phase_prep1(q, smem); break;
    }
    grid.sync();
  }
  phase_final(p, smem);
}

#endif

extern "C" void kernel_launch(void* const* d_in, const int* in_sizes, int n_in, void* d_out, int out_size, void* d_ws, size_t ws_size, hipStream_t stream) {
  static int grid_blocks = 0;
  if (!grid_blocks) {
    int dev = 0, cus = 0, per_cu = 0;
    hipGetDevice(&dev);
    hipDeviceGetAttribute(&cus, hipDeviceAttributeMultiprocessorCount, dev);
#if !MULTI
    hipOccupancyMaxActiveBlocksPerMultiprocessor(&per_cu, mega, NT, 0);
#else
    per_cu = 2;
#endif
    if (per_cu > 2) per_cu = 2;
    grid_blocks = cus * per_cu;
    if (ws_size < WS_END) fprintf(stderr, "kernel_launch: workspace too small: %zu < %zu\n", ws_size, (size_t)WS_END);
  }
  if (ws_size < WS_END || grid_blocks <= 0) return;
  Params p{};
  const float** f = (const float**)&p;
  for (int i = 0; i < 22; ++i) f[i] = (const float*)d_in[i];
  p.out = (float*)d_out;
  char* ws = (char*)d_ws;
  p.ZX = (float*)(ws + WS_ZX); p.WA = (bfu*)(ws + WS_WA); p.WO1 = (bfu*)(ws + WS_WO1); p.mod = (float*)(ws + WS_MOD);
  p.cs64 = (float*)(ws + WS_CS64); p.cs256 = (float*)(ws + WS_CS256); p.ctr = (int*)(ws + WS_CTR); p.G = (bfu*)(ws + WS_G);
#if MULTI
  const int GRD = 512;
#define LAUNCH(OP, LY, g) hipLaunchKernelGGL((phase_kernel<OP, LY>), dim3(GRD), dim3(NT), 0, stream, p, g)
  LAUNCH(0, 0, 0);
  for (int g = 0; g < NG; ++g) { LAUNCH(1, 0, g); LAUNCH(2, 0, g); LAUNCH(4, 0, g); LAUNCH(5, 0, g); LAUNCH(6, 0, g); }
  LAUNCH(7, 0, 0);
  for (int g = 0; g < NG; ++g) { LAUNCH(1, 1, g); LAUNCH(2, 1, g); LAUNCH(3, 1, g); LAUNCH(4, 1, g); LAUNCH(5, 1, g); LAUNCH(6, 1, g); }
  LAUNCH(8, 0, 0);
#else
  void* args[] = {&p};
  hipError_t e = hipLaunchCooperativeKernel((void*)mega, dim3(grid_blocks), dim3(NT), args, 0, stream);
  if (e != hipSuccess) fprintf(stderr, "cooperative launch failed: %s (grid %d)\n", hipGetErrorString(e), grid_blocks);
#endif
}
```

```cpp
#include <hip/hip_runtime.h>
#include <hip/hip_cooperative_groups.h>
#include <cstdio>
#include <cstdint>
namespace cg = cooperative_groups;
#ifndef MULTI
#define MULTI 0
#endif

#define DI __device__ __forceinline__
typedef unsigned short bfu;
typedef __attribute__((ext_vector_type(8))) short bf16x8;
typedef __attribute__((ext_vector_type(4))) short bf16x4;
typedef __attribute__((ext_vector_type(16))) float f32x16;
typedef __attribute__((ext_vector_type(4))) float f32x4;
typedef __attribute__((ext_vector_type(4))) unsigned u32x4;
typedef __attribute__((ext_vector_type(2))) unsigned u32x2;
#define MFMA(a, b, c) __builtin_amdgcn_mfma_f32_32x32x16_bf16((a), (b), (c), 0, 0, 0)

constexpr int NB = 8, SEQ = 2048, CTX = 256, T = 2304, DM = 2048, MROWS = NB * T;
constexpr int GB = 2, NG = 4, MG = GB * T;
constexpr int N1 = 16512, N2 = 11136;
constexpr float LOG2E = 1.4426950408889634f;
constexpr float EPS = 1e-5f;
constexpr float ALPHA = 1.4142135623730951f;
constexpr int NT = 256;
constexpr int BK = 64, LDT = BK + 8;
constexpr int SMEM_BYTES = 2 * 2 * 128 * LDT * 2;
constexpr int CLD = 132;

struct KArgs { const float* in[22]; float* out; char* ws; };
struct Params {
  const unsigned long long* sp;
  float* out;
  char* ws;
  DI const float* x() const { return (const float*)sp[0]; }
  DI const float* c() const { return (const float*)sp[1]; }
  DI const float* ctx() const { return (const float*)sp[2]; }
  DI const float* c_ctx() const { return (const float*)sp[3]; }
  DI const float* ada_w() const { return (const float*)sp[4]; }
  DI const float* ada_b() const { return (const float*)sp[5]; }
  DI const float* ln_g() const { return (const float*)sp[6]; }
  DI const float* ln_b() const { return (const float*)sp[7]; }
  DI const float* ab_w_in() const { return (const float*)sp[8]; }
  DI const float* ab_b_if() const { return (const float*)sp[9]; }
  DI const float* diff_lam() const { return (const float*)sp[10]; }
  DI const float* diff_g() const { return (const float*)sp[11]; }
  DI const float* mlstm_g() const { return (const float*)sp[12]; }
  DI const float* ab_w_out() const { return (const float*)sp[13]; }
  DI const float* cd_w_in() const { return (const float*)sp[14]; }
  DI const float* ret_decay() const { return (const float*)sp[15]; }
  DI const float* ret_g() const { return (const float*)sp[16]; }
  DI const float* q_norm_g() const { return (const float*)sp[17]; }
  DI const float* w_uq() const { return (const float*)sp[18]; }
  DI const float* kv_norm_g() const { return (const float*)sp[19]; }
  DI const float* w_ukv() const { return (const float*)sp[20]; }
  DI const float* cd_w_out() const { return (const float*)sp[21]; }
};

constexpr size_t U = (size_t)MG * 2048 * 2;
constexpr size_t L0_QD = 0, L0_KD = U, L0_VT = 2 * U, L0_MQ = 3 * U, L0_MK = 3 * U + U / 2, L0_MKT = 4 * U, L0_MVT = 4 * U + U / 2,
                 L0_OG = 5 * U + U / 2, L0_GATE = 6 * U + U / 2, L0_OA = 8 * U + U / 2, L0_HN = 10 * U + U / 2, L0_SM = 12 * U + U / 2;
constexpr size_t L0_H = 13 * U, L0_MIX = 14 * U;
constexpr size_t L1_RQ = 0, L1_RK = U, L1_RKT = 2 * U, L1_RVT = 3 * U, L1_GATE = 4 * U, L1_Q = 6 * U, L1_K = 7 * U + U / 2, L1_VT = 9 * U,
                 L1_OA = 10 * U, L1_R = 11 * U, L1_QL = 15 * U, L1_KVL = 15 * U + U / 4, L1_SM = 15 * U + U / 2;
constexpr size_t L1_MIX = L1_RQ, L1_H = L1_OA;
constexpr size_t GREGION = 16 * U;
constexpr size_t SM_GI = 0, SM_GF = 2 * GB * 8 * T * 4, SM_DN = 2 * SM_GF, SM_SSQ = 3 * SM_GF, SM_SSK = SM_SSQ + (size_t)MG * 4 * 4, SM_GC = SM_SSK + (size_t)MG * 2 * 4;

constexpr size_t WS_ZX = 0;
constexpr size_t WS_WA = WS_ZX + (size_t)MROWS * 2048 * 4;
constexpr size_t WS_WO1 = WS_WA + (size_t)N1 * 2048 * 2;
constexpr size_t WS_MOD = WS_WO1 + (size_t)2048 * 4096 * 2;
constexpr size_t WS_CS64 = WS_MOD + 2 * 9 * 6144 * 4;
constexpr size_t WS_CS256 = WS_CS64 + 2048 * 32 * 2 * 4;
constexpr size_t WS_CTR = WS_CS256 + 2048 * 128 * 2 * 4;
constexpr size_t WS_BAR = WS_CTR + 4096;
constexpr size_t WS_G = WS_BAR + 16384;
constexpr size_t WS_END = WS_G + GREGION;
#define P_ZX ((float*)(p.ws + WS_ZX))
#define P_WA ((bfu*)(p.ws + WS_WA))
#define P_WO1 ((bfu*)(p.ws + WS_WO1))
#define P_MOD ((float*)(p.ws + WS_MOD))
#define P_CS64 ((float*)(p.ws + WS_CS64))
#define P_CS256 ((float*)(p.ws + WS_CS256))
#define P_CTR ((int*)(p.ws + WS_CTR))
constexpr size_t WA_W2 = 0, WA_WO2 = (size_t)N2 * 2048 * 2, WA_UQ = WA_WO2 + (size_t)2048 * 4096 * 2, WA_UKV = WA_UQ + (size_t)3072 * 512 * 2;

DI int TID() { int t = threadIdx.x; asm volatile("" : "+v"(t)); return t; }
DI char* OPQ(const void* ptr) { unsigned long long v = (unsigned long long)ptr; asm volatile("" : "+s"(v)); return (char*)v; }
DI int crow(int r, int hi) { return (r & 3) + 8 * (r >> 2) + 4 * hi; }
typedef __attribute__((ext_vector_type(2))) __bf16 bf16x2_t;
typedef __attribute__((ext_vector_type(2))) float f32x2_t;
DI unsigned cvtpk(float lo, float hi) { f32x2_t v = {lo, hi}; bf16x2_t b = __builtin_convertvector(v, bf16x2_t); return __builtin_bit_cast(unsigned, b); }
DI float bf2f(bfu v) { return __uint_as_float((unsigned)v << 16); }
DI float bflo(unsigned v) { return __uint_as_float(v << 16); }
DI float bfhi(unsigned v) { return __uint_as_float(v & 0xffff0000u); }
DI bf16x8 pack8f(const float* v) { u32x4 w = {cvtpk(v[0], v[1]), cvtpk(v[2], v[3]), cvtpk(v[4], v[5]), cvtpk(v[6], v[7])}; return __builtin_bit_cast(bf16x8, w); }
DI bf16x8 packacc(const f32x16& x, int s) {
  u32x4 w = {cvtpk(x[8 * s], x[8 * s + 1]), cvtpk(x[8 * s + 2], x[8 * s + 3]), cvtpk(x[8 * s + 4], x[8 * s + 5]), cvtpk(x[8 * s + 6], x[8 * s + 7])};
  return __builtin_bit_cast(bf16x8, w);
}
DI bf16x8 ld8(const bfu* p) { return *reinterpret_cast<const bf16x8*>(p); }
DI bf16x8 ld44(const bfu* p) {
  u32x2 a = *reinterpret_cast<const u32x2*>(p), b = *reinterpret_cast<const u32x2*>(p + 8);
  u32x4 w = {a[0], a[1], b[0], b[1]}; return __builtin_bit_cast(bf16x8, w);
}
DI void st8(bfu* p, bf16x8 v) { *reinterpret_cast<bf16x8*>(p) = v; }
DI void unpack8(bf16x8 v, float* f) { u32x4 w = __builtin_bit_cast(u32x4, v); for (int i = 0; i < 4; ++i) { f[2 * i] = bflo(w[i]); f[2 * i + 1] = bfhi(w[i]); } }
DI float silu(float v) { return v / (1.f + __expf(-v)); }
DI float sigm(float v) { return 1.f / (1.f + __expf(-v)); }
DI float logsig(float v) { return fminf(v, 0.f) - log1pf(__expf(-fabsf(v))); }
DI float wsum(float v) { for (int o = 32; o > 0; o >>= 1) v += __shfl_xor(v, o); return v; }
DI float wmax(float v) { for (int o = 32; o > 0; o >>= 1) v = fmaxf(v, __shfl_xor(v, o)); return v; }
DI float block_sum(float v, float* red) {
  v = wsum(v);
  __syncthreads();
  if ((TID() & 63) == 0) red[TID() >> 6] = v;
  __syncthreads();
  return red[0] + red[1] + red[2] + red[3];
}

DI int srccol1(int n) { return n < 12288 ? n : (n < 16384 ? n + 32 : (n < 16416 ? n - 4096 : -1)); }
DI int srccol2(int n) {
  if (n < 4096) { int base = n & ~255, j = n & 255, grp = j >> 6, w = j & 63; return base + (grp & 1) * 128 + (grp >> 1) * 64 + w; }
  if (n < 6976) return n;
  if (n < 7040) return -1;
  return n - 64;
}
DI void tr_load(const float* __restrict__ src, int ld, int K, int mapid, const float* __restrict__ ks, int tile, f32x4 (&v)[4]) {
  const int tid = TID();
  const int kT = K >> 6, nt = tile / kT, kt = tile % kT, n0 = nt * 64, k0 = kt * 64;
  const int n4 = (tid & 15) * 4, kr = tid >> 4;
  const int n = n0 + n4;
  const int sc = mapid == 1 ? srccol1(n) : (mapid == 2 ? srccol2(n) : n);
#pragma unroll
  for (int i = 0; i < 4; ++i) {
    const int k = i * 16 + kr;
    f32x4 x = {0.f, 0.f, 0.f, 0.f};
    if (sc >= 0) x = *reinterpret_cast<const f32x4*>(src + (long)(k0 + k) * ld + sc);
    if (ks) { const float g_ = ks[k0 + k]; x *= g_; }
    v[i] = x;
  }
}
DI void tr_finish(int K, bfu* __restrict__ dst, int tile, const f32x4 (&v)[4], float* tl) {
  const int tid = TID();
  const int kT = K >> 6, nt = tile / kT, kt = tile % kT, n0 = nt * 64, k0 = kt * 64;
  const int n4 = (tid & 15) * 4, kr = tid >> 4;
  __syncthreads();
#pragma unroll
  for (int i = 0; i < 4; ++i) {
    const int k = i * 16 + kr;
    tl[k * 65 + n4] = v[i][0]; tl[k * 65 + n4 + 1] = v[i][1]; tl[k * 65 + n4 + 2] = v[i][2]; tl[k * 65 + n4 + 3] = v[i][3];
  }
  __syncthreads();
  for (int i = 0; i < 2; ++i) {
    int n = i * 32 + (tid >> 3), k8 = (tid & 7) * 8;
    float o[8];
    for (int j = 0; j < 8; ++j) o[j] = tl[(k8 + j) * 65 + n];
    st8(dst + (long)(n0 + n) * K + k0 + k8, pack8f(o));
  }
}

DI void phase_prep0(const Params& p, char* smem) {
  float* tl = (float*)smem;
  const int tid = TID(), G_ = gridDim.x, b = blockIdx.x;
  if (b < 192) {
    for (int i = tid; i < 9 * 2048; i += NT) { const int r = i >> 11, k = i & 2047; tl[i] = silu(r < 8 ? p.c()[r * 2048 + k] : p.c_ctx()[k]); }
    __syncthreads();
    for (int it = b; it < 192; it += G_) {
      const int layer = it / 96, cg_ = it % 96, col = cg_ * 64 + (tid & 63), kq = tid >> 6;
      const float* w = p.ada_w() + (long)layer * 2048 * 6144 + col;
      float acc[9];
      for (int r = 0; r < 9; ++r) acc[r] = 0.f;
#pragma unroll 16
      for (int k = kq * 512; k < kq * 512 + 512; ++k) {
        const float wv = w[(long)k * 6144];
#pragma unroll
        for (int r = 0; r < 9; ++r) acc[r] += tl[r * 2048 + k] * wv;
      }
      __syncthreads();
      float* red = tl;
      for (int r = 0; r < 9; ++r) red[(kq * 9 + r) * 64 + (tid & 63)] = acc[r];
      __syncthreads();
      if (tid < 64) {
        for (int r = 0; r < 9; ++r) {
          float sm = red[r * 64 + tid] + red[(9 + r) * 64 + tid] + red[(18 + r) * 64 + tid] + red[(27 + r) * 64 + tid];
          P_MOD[((long)layer * 9 + r) * 6144 + col] = sm + p.ada_b()[layer * 6144 + col];
        }
      }
      __syncthreads();
    }
  }
  for (int i = b * NT + tid; i < 2048 * 160; i += G_ * NT) {
    int pos = i / 160, j = i % 160;
    float row = (float)(pos >> 6), col = (float)(pos & 63);
    if (j < 32) {
      int f = j & 15; float inv = powf(10000.f, -(float)f / 16.f); float ang = (j < 16 ? row : col) * inv;
      P_CS64[(pos * 32 + j) * 2] = cosf(ang); P_CS64[(pos * 32 + j) * 2 + 1] = sinf(ang);
    } else {
      int jj = j - 32, f = jj & 63; float inv = powf(10000.f, -(float)f / 64.f); float ang = (jj < 64 ? row : col) * inv;
      P_CS256[(pos * 128 + jj) * 2] = cosf(ang); P_CS256[(pos * 128 + jj) * 2 + 1] = sinf(ang);
    }
  }
  const int t1 = (N1 / 64) * 32, t2 = 32 * 64;
  {
    auto ld_ = [&](int it, f32x4 (&v)[4]) {
      if (it < t1) tr_load(p.ab_w_in(), 16416, 2048, 1, nullptr, it, v);
      else tr_load(p.ab_w_out(), 2048, 4096, 0, nullptr, it - t1, v);
    };
    auto fin_ = [&](int it, const f32x4 (&v)[4]) {
      if (it < t1) tr_finish(2048, P_WA, it, v, tl);
      else tr_finish(4096, P_WO1, it - t1, v, tl);
    };
    f32x4 va[4], vb[4];
    int it = b;
    if (it < t1 + t2) ld_(it, va);
    while (it < t1 + t2) {
      const int nx = it + G_;
      if (nx < t1 + t2) ld_(nx, vb);
      fin_(it, va);
#pragma unroll
      for (int i = 0; i < 4; ++i) va[i] = vb[i];
      it = nx;
    }
  }
}
DI void phase_prep1(const Params& p, char* smem) {
  float* tl = (float*)smem;
  const int G_ = gridDim.x, b = blockIdx.x;
  const int t1 = (N2 / 64) * 32, t2 = 32 * 64, t3 = 48 * 8, t4 = 64 * 4;
  bfu* wa = P_WA;
  {
    const int tot = t1 + t2 + t3 + t4;
    auto ld_ = [&](int it, f32x4 (&v)[4]) {
      if (it < t1) tr_load(p.cd_w_in(), 11072, 2048, 2, nullptr, it, v);
      else if (it < t1 + t2) tr_load(p.cd_w_out(), 2048, 4096, 0, nullptr, it - t1, v);
      else if (it < t1 + t2 + t3) tr_load(p.w_uq(), 3072, 512, 0, p.q_norm_g(), it - t1 - t2, v);
      else tr_load(p.w_ukv(), 4096, 256, 0, p.kv_norm_g(), it - t1 - t2 - t3, v);
    };
    auto fin_ = [&](int it, const f32x4 (&v)[4]) {
      if (it < t1) tr_finish(2048, (bfu*)((char*)wa + WA_W2), it, v, tl);
      else if (it < t1 + t2) tr_finish(4096, (bfu*)((char*)wa + WA_WO2), it - t1, v, tl);
      else if (it < t1 + t2 + t3) tr_finish(512, (bfu*)((char*)wa + WA_UQ), it - t1 - t2, v, tl);
      else tr_finish(256, (bfu*)((char*)wa + WA_UKV), it - t1 - t2 - t3, v, tl);
    };
    f32x4 va[4], vb[4];
    int it = b;
    if (it < tot) ld_(it, va);
    while (it < tot) {
      const int nx = it + G_;
      if (nx < tot) ld_(nx, vb);
      fin_(it, va);
#pragma unroll
      for (int i = 0; i < 4; ++i) va[i] = vb[i];
      it = nx;
    }
  }
}

DI void row_ln(float (&v)[32], const float* __restrict__ g, const float* __restrict__ bta, int lane) {
  float sm = 0.f;
#pragma unroll
  for (int i = 0; i < 32; ++i) sm += v[i];
  const float mean = wsum(sm) * (1.f / DM);
  float sq = 0.f;
#pragma unroll
  for (int i = 0; i < 32; ++i) { v[i] -= mean; sq += v[i] * v[i]; }
  const float rstd = rsqrtf(wsum(sq) * (1.f / DM) + EPS);
#pragma unroll
  for (int j = 0; j < 8; ++j) {
    const f32x4 gg = *(const f32x4*)(g + lane * 4 + 256 * j), bb = *(const f32x4*)(bta + lane * 4 + 256 * j);
#pragma unroll
    for (int e = 0; e < 4; ++e) v[4 * j + e] = v[4 * j + e] * rstd * gg[e] + bb[e];
  }
}
DI void phase_mod(const Params& p, int g, int layer, char* smem) {
  (void)smem;
  const int tid = TID(), lane = tid & 63, w = tid >> 6;
  bfu* h = (bfu*)(OPQ(p.ws + WS_G) + (layer == 0 ? L0_H : L1_H));
  for (int i = blockIdx.x * 4 + w; i < MG; i += gridDim.x * 4) {
    const long r = (long)g * MG + i; const int b = (int)(r / T), t = (int)(r % T);
    float v[32];
    if (layer == 0) {
      const float* s = t < CTX ? p.ctx() + ((long)b * CTX + t) * DM : p.x() + ((long)b * SEQ + (t - CTX)) * DM;
#pragma unroll
      for (int j = 0; j < 8; ++j) { const f32x4 a = *(const f32x4*)(s + lane * 4 + 256 * j); v[4 * j] = a[0]; v[4 * j + 1] = a[1]; v[4 * j + 2] = a[2]; v[4 * j + 3] = a[3]; }
    } else {
      float* s = P_ZX + r * DM;
#pragma unroll
      for (int j = 0; j < 8; ++j) { const f32x4 a = *(const f32x4*)(s + lane * 4 + 256 * j); v[4 * j] = a[0]; v[4 * j + 1] = a[1]; v[4 * j + 2] = a[2]; v[4 * j + 3] = a[3]; }
      row_ln(v, p.ln_g(), p.ln_b(), lane);
#pragma unroll
      for (int j = 0; j < 8; ++j) { const f32x4 o = {v[4 * j], v[4 * j + 1], v[4 * j + 2], v[4 * j + 3]}; *(f32x4*)(s + lane * 4 + 256 * j) = o; }
    }
    const float* md = P_MOD + ((long)layer * 9 + (t < CTX ? 8 : b)) * 6144;
    f32x4 shv[8], scv[8];
#pragma unroll
    for (int j = 0; j < 8; ++j) { shv[j] = *(const f32x4*)(md + lane * 4 + 256 * j); scv[j] = *(const f32x4*)(md + 2048 + lane * 4 + 256 * j); }
#pragma unroll
    for (int j = 0; j < 8; ++j) {
      const f32x4 sh = shv[j], sc = scv[j];
      u32x2 o = {cvtpk(v[4 * j] * (1.f + sc[0]) + sh[0], v[4 * j + 1] * (1.f + sc[1]) + sh[1]), cvtpk(v[4 * j + 2] * (1.f + sc[2]) + sh[2], v[4 * j + 3] * (1.f + sc[3]) + sh[3])};
      *reinterpret_cast<u32x2*>(h + (long)i * DM + lane * 4 + 256 * j) = o;
    }
  }
}
DI void phase_final(const Params& p, char* smem) {
  (void)smem;
  const int tid = TID(), lane = tid & 63, w = tid >> 6;
  for (int i = blockIdx.x * 4 + w; i < NB * SEQ; i += gridDim.x * 4) {
    const int b = i / SEQ, pos = i % SEQ;
    const float* s = P_ZX + ((long)b * T + CTX + pos) * DM;
    float v[32];
#pragma unroll
    for (int j = 0; j < 8; ++j) { const f32x4 a = *(const f32x4*)(s + lane * 4 + 256 * j); v[4 * j] = a[0]; v[4 * j + 1] = a[1]; v[4 * j + 2] = a[2]; v[4 * j + 3] = a[3]; }
    row_ln(v, p.ln_g() + DM, p.ln_b() + DM, lane);
    float* d = p.out + (long)i * DM;
#pragma unroll
    for (int j = 0; j < 8; ++j) { const f32x4 o = {v[4 * j], v[4 * j + 1], v[4 * j + 2], v[4 * j + 3]}; *(f32x4*)(d + lane * 4 + 256 * j) = o; }
  }
}

DI void gemm_tile(const bfu* __restrict__ A, int lda, const bfu* __restrict__ Bt, int ldb, int K, char* smem) {
  const int tid = TID(), lane = tid & 63, w = tid >> 6, wm = w >> 1, wn = w & 1, l32 = lane & 31, hi = lane >> 5;
  bfu* As = (bfu*)smem; bfu* Bs = As + 2 * 128 * LDT;
  const int sr = tid >> 3, sc = (tid & 7) * 8;
  const bfu* Ag = A + (long)sr * lda + sc; const bfu* Bg = Bt + (long)sr * ldb + sc;
  bf16x8 ra0[4], rb0[4], ra1[4], rb1[4];
#define G_LOAD(RA, RB, kt_)                                                                              \
  _Pragma("unroll") for (int i = 0; i < 4; ++i) { RA[i] = ld8(Ag + (long)(32 * i) * lda + (kt_) * BK); RB[i] = ld8(Bg + (long)(32 * i) * ldb + (kt_) * BK); }
#define G_STORE(RA, RB, buf_)                                                                            \
  _Pragma("unroll") for (int i = 0; i < 4; ++i) { st8(As + (buf_) * 128 * LDT + (sr + 32 * i) * LDT + sc, RA[i]); st8(Bs + (buf_) * 128 * LDT + (sr + 32 * i) * LDT + sc, RB[i]); }
#define G_COMPUTE(buf_)                                                                                  \
  do {                                                                                                   \
    const bfu* as = As + (buf_) * 128 * LDT + (wm * 64 + l32) * LDT + hi * 8;                            \
    const bfu* bs = Bs + (buf_) * 128 * LDT + (wn * 64 + l32) * LDT + hi * 8;                            \
    _Pragma("unroll") for (int ks = 0; ks < 4; ++ks) {                                                   \
      bf16x8 a0 = ld8(as + ks * 16), a1 = ld8(as + 32 * LDT + ks * 16), b0 = ld8(bs + ks * 16), b1 = ld8(bs + 32 * LDT + ks * 16); \
      acc[0][0] = MFMA(a0, b0, acc[0][0]); acc[0][1] = MFMA(a0, b1, acc[0][1]);                          \
      acc[1][0] = MFMA(a1, b0, acc[1][0]); acc[1][1] = MFMA(a1, b1, acc[1][1]);                          \
    }                                                                                                    \
  } while (0)
  const int nk = K / BK;
  G_LOAD(ra0, rb0, 0);
  G_LOAD(ra1, rb1, 1);
  f32x16 acc[2][2];
#pragma unroll
  for (int i = 0; i < 2; ++i)
#pragma unroll
    for (int j = 0; j < 2; ++j)
#pragma unroll
      for (int r = 0; r < 16; ++r) acc[i][j][r] = 0.f;
  __syncthreads();
  G_STORE(ra0, rb0, 0);
  if (2 < nk) { G_LOAD(ra0, rb0, 2); }
  __syncthreads();
  for (int kt = 0; kt < nk; kt += 2) {
    G_COMPUTE(0);
    G_STORE(ra1, rb1, 1);
    if (kt + 3 < nk) { G_LOAD(ra1, rb1, kt + 3); }
    __syncthreads();
    G_COMPUTE(1);
    if (kt + 2 < nk) { G_STORE(ra0, rb0, 0); }
    if (kt + 4 < nk) { G_LOAD(ra0, rb0, kt + 4); }
    __syncthreads();
  }
#undef G_LOAD
#undef G_STORE
#undef G_COMPUTE
  float* Cs = (float*)smem;
#pragma unroll
  for (int mi = 0; mi < 2; ++mi)
#pragma unroll
    for (int ni = 0; ni < 2; ++ni)
#pragma unroll
      for (int r = 0; r < 16; ++r) Cs[(wm * 64 + mi * 32 + crow(r, hi)) * CLD + wn * 64 + ni * 32 + l32] = acc[mi][ni][r];
  __syncthreads();
}
DI void gemm_preload(const bfu* __restrict__ A, const bfu* __restrict__ Bt, int K, int kt, bf16x8 (&ra)[4], bf16x8 (&rb)[8]) {
  const int tid = TID(), sr = tid >> 3, sc = (tid & 7) * 8;
  const bfu* Ag = A + (long)sr * K + sc + kt * BK; const bfu* Bg = Bt + (long)sr * K + sc + kt * BK;
#pragma unroll
  for (int i = 0; i < 4; ++i) ra[i] = ld8(Ag + (long)(32 * i) * K);
#pragma unroll
  for (int i = 0; i < 8; ++i) rb[i] = ld8(Bg + (long)(32 * i) * K);
}
DI void gemm_main2(const bfu* __restrict__ A, const bfu* __restrict__ Bt, int K, char* smem, f32x16 (&acc)[2][4], bf16x8 (&ra)[4], bf16x8 (&rb)[8]) {
  const int tid = TID(), lane = tid & 63, w = tid >> 6, wm = w >> 1, wn = w & 1, l32 = lane & 31, hi = lane >> 5;
  bfu* As = (bfu*)smem; bfu* Bs = As + 128 * LDT;
  const int sr = tid >> 3, sc = (tid & 7) * 8;
#pragma unroll
  for (int i = 0; i < 2; ++i)
#pragma unroll
    for (int j = 0; j < 4; ++j)
#pragma unroll
      for (int r = 0; r < 16; ++r) acc[i][j][r] = 0.f;
  const int nk = K / BK;
  const bfu* as = As + (wm * 64 + l32) * LDT + hi * 8;
  const bfu* bs = Bs + (wn * 128 + l32) * LDT + hi * 8;
  for (int kt = 0; kt < nk; ++kt) {
    __syncthreads();
#pragma unroll
    for (int i = 0; i < 4; ++i) st8(As + (sr + 32 * i) * LDT + sc, ra[i]);
#pragma unroll
    for (int i = 0; i < 8; ++i) st8(Bs + (sr + 32 * i) * LDT + sc, rb[i]);
    __syncthreads();
    if (kt + 1 < nk) gemm_preload(A, Bt, K, kt + 1, ra, rb);
#pragma unroll
    for (int ks = 0; ks < 4; ++ks) {
      const bf16x8 a0 = ld8(as + ks * 16), a1 = ld8(as + 32 * LDT + ks * 16);
#pragma unroll
      for (int j = 0; j < 4; ++j) {
        const bf16x8 b = ld8(bs + j * 32 * LDT + ks * 16);
        acc[0][j] = MFMA(a0, b, acc[0][j]); acc[1][j] = MFMA(a1, b, acc[1][j]);
      }
    }
  }
}
DI void acc_half_to_lds(float* Cs, const f32x16 (&acc)[2][4], int h) {
  const int tid = TID(), lane = tid & 63, w = tid >> 6, wm = w >> 1, wn = w & 1, l32 = lane & 31, hi = lane >> 5;
  __syncthreads();
  if (wn == h) {
#pragma unroll
    for (int mi = 0; mi < 2; ++mi)
#pragma unroll
      for (int ni = 0; ni < 4; ++ni)
#pragma unroll
        for (int r = 0; r < 16; ++r) Cs[(wm * 64 + mi * 32 + crow(r, hi)) * CLD + ni * 32 + l32] = acc[mi][ni][r];
  }
  __syncthreads();
}
DI void ldrow8(const float* Cs, int row, int c, float* v) {
  f32x4 a = *(const f32x4*)(Cs + row * CLD + c), b = *(const f32x4*)(Cs + row * CLD + c + 4);
  for (int j = 0; j < 4; ++j) { v[j] = a[j]; v[4 + j] = b[j]; }
}
DI void store_R(const float* Cs, int cb, int nc, bfu* dst, long ld, float scale, const float* rs = nullptr) {
  const int cpr = nc >> 3;
  for (int u = TID(); u < 128 * cpr; u += NT) {
    int row = u / cpr, c8 = (u % cpr) * 8; float v[8]; ldrow8(Cs, row, cb + c8, v);
    float s = rs ? scale * rs[row] : scale;
    for (int j = 0; j < 8; ++j) v[j] *= s;
    st8(dst + row * ld + c8, pack8f(v));
  }
}
DI void store_T(const float* Cs, int cb, int nc, bfu* dst, long ldT, float scale, const float* rs = nullptr) {
  for (int u = TID(); u < nc * 16; u += NT) {
    int c = u % nc, rc = (u / nc) * 8; float v[8];
    for (int j = 0; j < 8; ++j) v[j] = Cs[(rc + j) * CLD + cb + c] * (rs ? scale * rs[rc + j] : scale);
    st8(dst + c * ldT + rc, pack8f(v));
  }
}
DI void rope_inplace(float* Cs, int cb, int HALF, const float* cs, int tstride, int idx0, int pos0) {
  const int cpr = HALF >> 3;
  for (int u = TID(); u < 128 * cpr; u += NT) {
    int row = u / cpr, c8 = (u % cpr) * 8; float a[8], b[8];
    ldrow8(Cs, row, cb + c8, a); ldrow8(Cs, row, cb + HALF + c8, b);
    const float* t = cs + (long)(pos0 + row) * tstride + (idx0 + c8) * 2;
    for (int j = 0; j < 8; ++j) { float co = t[2 * j], si = t[2 * j + 1]; float x1 = a[j], x2 = b[j]; a[j] = x1 * co - x2 * si; b[j] = x1 * si + x2 * co; }
    f32x4 o;
    o = (f32x4){a[0], a[1], a[2], a[3]}; *(f32x4*)(Cs + row * CLD + cb + c8) = o;
    o = (f32x4){a[4], a[5], a[6], a[7]}; *(f32x4*)(Cs + row * CLD + cb + c8 + 4) = o;
    o = (f32x4){b[0], b[1], b[2], b[3]}; *(f32x4*)(Cs + row * CLD + cb + HALF + c8) = o;
    o = (f32x4){b[4], b[5], b[6], b[7]}; *(f32x4*)(Cs + row * CLD + cb + HALF + c8 + 4) = o;
  }
  __syncthreads();
}

DI void epi_in0(const Params& p, float* Cs, int m0, int n0) {
  char* G = OPQ(p.ws + WS_G);
  const int bg = m0 / T, t0 = m0 % T; const bool lat = t0 >= CTX;
  if (n0 < 4096) {
    const bool isq = n0 < 2048; const int head = (n0 & 2047) >> 7;
    if (lat) { rope_inplace(Cs, 0, 32, P_CS64, 64, 0, t0 - CTX); rope_inplace(Cs, 64, 32, P_CS64, 64, 0, t0 - CTX); }
    bfu* dst = (bfu*)(G + (isq ? L0_QD : L0_KD));
    for (int m = 0; m < 2; ++m) store_R(Cs, m * 64, 64, dst + ((long)(bg * 32 + head * 2 + m) * T + t0) * 64, 64, isq ? 0.125f * LOG2E : 1.f);
  } else if (n0 < 6144) {
    const int head = (n0 - 4096) >> 7;
    store_T(Cs, 0, 128, (bfu*)(G + L0_VT) + ((long)(bg * 16 + head) * 128) * T + t0, T, 1.f);
  } else if (n0 < 7168) {
    const int head = (n0 - 6144) >> 7;
    store_R(Cs, 0, 128, (bfu*)(G + L0_MQ) + ((long)(bg * 8 + head) * T + t0) * 128, 128, 0.08838834764831845f);
  } else if (n0 < 8192) {
    const int head = (n0 - 7168) >> 7;
    store_R(Cs, 0, 128, (bfu*)(G + L0_MK) + ((long)(bg * 8 + head) * T + t0) * 128, 128, 1.f);
    store_T(Cs, 0, 128, (bfu*)(G + L0_MKT) + ((long)(bg * 8 + head) * 128) * T + t0, T, 1.f);
  } else if (n0 < 10240) {
    const int head = (n0 - 8192) >> 8, d0 = (n0 - 8192) & 255;
    store_T(Cs, 0, 128, (bfu*)(G + L0_MVT) + ((long)(bg * 8 + head) * 256 + d0) * T + t0, T, 1.f);
  } else if (n0 < 12288) {
    store_R(Cs, 0, 128, (bfu*)(G + L0_OG) + (long)m0 * 2048 + (n0 - 10240), 2048, 1.f);
  } else if (n0 < 16384) {
    store_R(Cs, 0, 128, (bfu*)(G + L0_GATE) + (long)m0 * 4096 + (n0 - 12288), 4096, 1.f);
  } else {
    float* gb = (float*)(G + L0_SM + SM_GI); float* gsv = (float*)(G + L0_SM + SM_GF); float* gc = (float*)(G + L0_SM + SM_GC);
    const int tid = TID(), w = tid >> 6, lane = tid & 63;
    for (int sidx = w; sidx < 32; sidx += 4) {
      const int ch = sidx & 1, dh = sidx >> 1, dir = dh >> 3, head = dh & 7, row = ch * 64 + lane;
      const float ig = Cs[row * CLD + dir * 8 + head] + p.ab_b_if()[dir * 8 + head];
      const float f = logsig(Cs[row * CLD + 16 + dir * 8 + head] + p.ab_b_if()[16 + dir * 8 + head]);
      float bc = f;
      for (int off = 1; off < 64; off <<= 1) {
        const float yu = __shfl_up(bc, off), yd = __shfl_down(bc, off);
        const bool ok = dir == 0 ? lane >= off : lane + off < 64;
        if (ok) bc += dir == 0 ? yu : yd;
      }
      const float gs = ig - bc;
      float cm = gs;
      for (int off = 1; off < 64; off <<= 1) {
        const float yu = __shfl_up(cm, off), yd = __shfl_down(cm, off);
        const bool ok = dir == 0 ? lane >= off : lane + off < 64;
        if (ok) cm = fmaxf(cm, dir == 0 ? yu : yd);
      }
      const long o = ((long)(dir * GB + bg) * 8 + head) * T + t0 + row;
      gb[o] = bc; gsv[o] = gs; gc[o] = cm;
    }
  }
}
DI void epi_in1(const Params& p, float* Cs, int m0, int n0) {
  char* G = OPQ(p.ws + WS_G);
  const int bg = m0 / T, t0 = m0 % T; const bool lat = t0 >= CTX;
  if (n0 < 4096) {
    const bool isq = n0 < 2048; const int head = (n0 & 2047) >> 8, par = (n0 >> 7) & 1;
    if (lat) rope_inplace(Cs, 0, 64, P_CS256, 256, par * 64, t0 - CTX);
    bfu* dst = (bfu*)(G + (isq ? L1_RQ : L1_RK)) + ((long)(bg * 8 + head) * T + t0) * 256;
    const float sc = isq ? 1.f : 0.0625f;
    store_R(Cs, 0, 64, dst + par * 64, 256, sc); store_R(Cs, 64, 64, dst + 128 + par * 64, 256, sc);
    if (!isq) {
      bfu* dT = (bfu*)(G + L1_RKT) + ((long)(bg * 8 + head) * 256) * T + t0;
      store_T(Cs, 0, 64, dT + (long)(par * 64) * T, T, sc); store_T(Cs, 64, 64, dT + (long)(128 + par * 64) * T, T, sc);
    }
  } else if (n0 < 6144) {
    const int head = (n0 - 4096) >> 8, d0 = (n0 - 4096) & 255;
    store_T(Cs, 0, 128, (bfu*)(G + L1_RVT) + ((long)(bg * 8 + head) * 256 + d0) * T + t0, T, 1.f);
  } else if (n0 < 6912) {
    const bool isq = n0 < 6656; const int j = isq ? (n0 - 6144) >> 7 : (n0 - 6656) >> 7;
    if (isq) store_R(Cs, 0, 128, (bfu*)(G + L1_QL) + (long)m0 * 512 + j * 128, 512, 1.f);
    else store_R(Cs, 0, 128, (bfu*)(G + L1_KVL) + (long)m0 * 256 + j * 128, 256, 1.f);
    float* ss = (float*)(G + L1_SM + (isq ? SM_SSQ : SM_SSK));
    for (int u = TID(); u < 2048; u += NT) {
      int row = u >> 4, c8 = (u & 15) * 8; float v[8]; ldrow8(Cs, row, c8, v);
      float s = 0; for (int jj = 0; jj < 8; ++jj) s += v[jj] * v[jj];
      s += __shfl_xor(s, 1); s += __shfl_xor(s, 2); s += __shfl_xor(s, 4); s += __shfl_xor(s, 8);
      if ((u & 15) == 0) ss[(long)(m0 + row) * (isq ? 4 : 2) + j] = s;
    }
  } else if (n0 < 7040) {
    if (lat) rope_inplace(Cs, 0, 32, P_CS64, 64, 0, t0 - CTX);
    for (int hh = 0; hh < 16; ++hh) store_R(Cs, 0, 64, (bfu*)(G + L1_K) + ((long)(bg * 16 + hh) * T + t0) * 192 + 128, 192, 1.f);
  } else {
    store_R(Cs, 0, 128, (bfu*)(G + L1_GATE) + (long)m0 * 4096 + (n0 - 7040), 4096, 1.f);
  }
}
DI void epi_uq(const Params& p, float* Cs, int m0, int n0, const float* rsl) {
  char* G = OPQ(p.ws + WS_G);
  const int bg = m0 / T, t0 = m0 % T; const bool lat = t0 >= CTX;
  for (int gq = 0; gq < 2; ++gq) {
    int gi = (n0 >> 6) + gq, head = gi / 3, part = gi % 3;
    if (part == 2 && lat) rope_inplace(Cs, gq * 64, 32, P_CS64, 64, 0, t0 - CTX);
    store_R(Cs, gq * 64, 64, (bfu*)(G + L1_Q) + ((long)(bg * 16 + head) * T + t0) * 192 + part * 64, 192, 0.07216878364870323f * LOG2E, rsl);
  }
}
DI void epi_ukv(const Params& p, float* Cs, int m0, int n0, const float* rsl) {
  char* G = OPQ(p.ws + WS_G);
  const int bg = m0 / T, t0 = m0 % T; const int head = n0 >> 8;
  if ((n0 & 255) == 0) store_R(Cs, 0, 128, (bfu*)(G + L1_K) + ((long)(bg * 16 + head) * T + t0) * 192, 192, 1.f, rsl);
  else store_T(Cs, 0, 128, (bfu*)(G + L1_VT) + ((long)(bg * 16 + head) * 128) * T + t0, T, 1.f, rsl);
}
DI void epi_out(const Params& p, const float* Cs, int g, int layer, int m0, int n0) {
  for (int u = TID(); u < 2048; u += NT) {
    int row = u >> 4, c8 = (u & 15) * 8; float v[8]; ldrow8(Cs, row, c8, v);
    long r = (long)g * MG + m0 + row; int b = (int)(r / T), t = (int)(r % T);
    float* z = P_ZX + r * DM + n0 + c8;
    const float* xs = layer == 0 ? (t < CTX ? p.ctx() + ((long)b * CTX + t) * DM : p.x() + ((long)b * SEQ + (t - CTX)) * DM) + n0 + c8 : z;
    const float* gt = P_MOD + ((long)layer * 9 + (t < CTX ? 8 : b)) * 6144 + 4096 + n0 + c8;
    f32x4 x0 = *(const f32x4*)xs, x1 = *(const f32x4*)(xs + 4), o0, o1;
    for (int j = 0; j < 4; ++j) { o0[j] = ALPHA * x0[j] + gt[j] * v[j]; o1[j] = ALPHA * x1[j] + gt[4 + j] * v[4 + j]; }
    *(f32x4*)z = o0; *(f32x4*)(z + 4) = o1;
  }
}

DI void store_T_regs(const f32x16 (&acc)[2][4], int h, bfu* dst, const float* rs) {
  const int tid = TID(), lane = tid & 63, w = tid >> 6, wm = w >> 1, wn = w & 1, l32 = lane & 31, hi = lane >> 5;
  if (wn != h) return;
#pragma unroll
  for (int mi = 0; mi < 2; ++mi)
#pragma unroll
    for (int ni = 0; ni < 4; ++ni)
#pragma unroll
      for (int rg = 0; rg < 4; ++rg) {
        const int row = wm * 64 + mi * 32 + 8 * rg + 4 * hi;
        float s0 = 1.f, s1 = 1.f, s2 = 1.f, s3 = 1.f;
        if (rs) { s0 = rs[row]; s1 = rs[row + 1]; s2 = rs[row + 2]; s3 = rs[row + 3]; }
        const u32x2 v = {cvtpk(acc[mi][ni][4 * rg] * s0, acc[mi][ni][4 * rg + 1] * s1), cvtpk(acc[mi][ni][4 * rg + 2] * s2, acc[mi][ni][4 * rg + 3] * s3)};
        *reinterpret_cast<u32x2*>(dst + (long)(ni * 32 + l32) * T + row) = v;
      }
}
DI int nt_map0(int v) { return v < 16 ? 24 + v : (v == 16 ? 64 : (v < 41 ? v - 17 : v - 1)); }
DI void phase_gemm(const Params& p, int g, int kind, char* smem, float* rsl, int* s_item, int vlo, int vhi, int cslot) {
  char* G = OPQ(p.ws + WS_G); float* Cs = (float*)smem;
  const int MT = MG / 128;
  int ntn, nvalid;
  if (kind == 0) { ntn = (N1 + 255) / 256; nvalid = N1 / 128; } else if (kind == 1) { ntn = (N2 + 255) / 256; nvalid = N2 / 128; }
  else if (kind == 2) { ntn = 12 + 16; nvalid = 56; } else { ntn = 8; nvalid = 16; }
  (void)ntn;
  const int nvt = vhi - vlo, total = MT * nvt;
  const int xcd = blockIdx.x & 7;
  int* qctr = P_CTR + 256 + (g * 8 + cslot) * 8 + xcd;
  struct TD { const bfu* A; const bfu* Bt; int K, m0, n0, nt; bool ok; };
  auto fetch = [&](TD& d) {
    for (;;) {
      __syncthreads();
      if (TID() == 0) *s_item = atomicAdd(qctr, 1);
      __syncthreads();
      const int kq = *s_item;
      const int tile = ((kq >> 6) * 8 + xcd) * 64 + (kq & 63);
      if (tile >= total) { d.ok = false; return; }
      const int strip = tile / (MT * 8), rem = tile - strip * (MT * 8);
      const int wdt = min(8, nvt - strip * 8);
      const int mt = rem / wdt, vt = vlo + strip * 8 + rem % wdt;
      d.nt = kind == 0 ? nt_map0(vt) : vt; d.m0 = mt * 128; d.n0 = d.nt * 256;
      if (kind == 0) { d.A = (const bfu*)(G + L0_H) + (long)d.m0 * 2048; d.Bt = P_WA + (long)d.n0 * 2048; d.K = 2048; }
      else if (kind == 1) { d.A = (const bfu*)(G + L1_H) + (long)d.m0 * 2048; d.Bt = (const bfu*)((char*)P_WA + WA_W2) + (long)d.n0 * 2048; d.K = 2048; }
      else if (kind == 2) {
        if (d.nt < 12) { d.A = (const bfu*)(G + L1_QL) + (long)d.m0 * 512; d.Bt = (const bfu*)((char*)P_WA + WA_UQ) + (long)d.n0 * 512; d.K = 512; }
        else { d.n0 -= 12 * 256; d.A = (const bfu*)(G + L1_KVL) + (long)d.m0 * 256; d.Bt = (const bfu*)((char*)P_WA + WA_UKV) + (long)d.n0 * 256; d.K = 256; }
      } else {
        const int layer = kind - 3;
        if (layer == 1 && (d.m0 % T) < CTX) continue;
        d.A = (const bfu*)(G + (layer == 0 ? L0_MIX : L1_MIX)) + (long)d.m0 * 4096;
        d.Bt = (layer == 0 ? P_WO1 : (const bfu*)((char*)P_WA + WA_WO2)) + (long)d.n0 * 4096; d.K = 4096;
      }
      d.ok = true; return;
    }
  };
  TD cur; fetch(cur);
  bf16x8 ra[4], rb[8];
  if (cur.ok) gemm_preload(cur.A, cur.Bt, cur.K, 0, ra, rb);
  while (cur.ok) {
    const int m0 = cur.m0, n0 = cur.n0, nt = cur.nt;
    if (kind == 2) {
      const bool uq = nt < 12;
      __syncthreads();
      if (TID() < 128) {
        float s;
        if (uq) { const float* q = (const float*)(G + L1_SM + SM_SSQ) + (long)(m0 + TID()) * 4; s = (q[0] + q[1] + q[2] + q[3]) * (1.f / 512.f); }
        else { const float* q = (const float*)(G + L1_SM + SM_SSK) + (long)(m0 + TID()) * 2; s = (q[0] + q[1]) * (1.f / 256.f); }
        rsl[TID()] = rsqrtf(s + EPS);
      }
    }
    f32x16 acc[2][4];
    gemm_main2(cur.A, cur.Bt, cur.K, smem, acc, ra, rb);
    TD nxt; fetch(nxt);
    if (nxt.ok) gemm_preload(nxt.A, nxt.Bt, nxt.K, 0, ra, rb);
#pragma unroll
    for (int h = 0; h < 2; ++h) {
      if (nt * 2 + h >= nvalid) break;
      const int nh = n0 + h * 128;
      {
        const int bgq = m0 / T, t0q = m0 % T; bfu* td = nullptr; const float* trs = nullptr;
        if (kind == 0 && nh >= 4096 && nh < 6144) td = (bfu*)(G + L0_VT) + ((long)(bgq * 16 + ((nh - 4096) >> 7)) * 128) * T + t0q;
        else if (kind == 0 && nh >= 8192 && nh < 10240) td = (bfu*)(G + L0_MVT) + ((long)(bgq * 8 + ((nh - 8192) >> 8)) * 256 + ((nh - 8192) & 255)) * T + t0q;
        else if (kind == 1 && nh >= 4096 && nh < 6144) td = (bfu*)(G + L1_RVT) + ((long)(bgq * 8 + ((nh - 4096) >> 8)) * 256 + ((nh - 4096) & 255)) * T + t0q;
        else if (kind == 2 && nt >= 12 && (nh & 255) == 128) { td = (bfu*)(G + L1_VT) + ((long)(bgq * 16 + (nh >> 8)) * 128) * T + t0q; trs = rsl; }
        if (td) { store_T_regs(acc, h, td, trs); continue; }
      }
      acc_half_to_lds(Cs, acc, h);
      if (kind == 0) epi_in0(p, Cs, m0, nh);
      else if (kind == 1) epi_in1(p, Cs, m0, nh);
      else if (kind == 2) { if (nt < 12) epi_uq(p, Cs, m0, nh, rsl); else epi_ukv(p, Cs, m0, nh, rsl); }
      else epi_out(p, Cs, g, kind - 3, m0, nh);
    }
    cur = nxt;
  }
}

template <int DK, int KT>
DI void attn_item(const bfu* __restrict__ Qp, const bfu* __restrict__ Kp, const bfu* __restrict__ Vtp, int nkeys, bfu* __restrict__ Op, int ldo, char* smem) {
  constexpr int LK = DK + 8, LV = KT + 8, NKS = DK / 16, CPR = DK / 8, KCH = KT * CPR / NT, VPR = KT / 8, VCH = 128 * VPR / NT, NBK = KT / 32;
  bfu* Ks = (bfu*)smem; bfu* Vs = Ks + KT * LK;
  const int tid = TID(), lane = tid & 63, w = tid >> 6, l32 = lane & 31, hi = lane >> 5;
  bf16x8 qf[NKS];
  {
    const bfu* qrow = Qp + (long)(w * 32 + l32) * DK + hi * 8;
#pragma unroll
    for (int ks = 0; ks < NKS; ++ks) qf[ks] = ld8(qrow + ks * 16);
  }
  f32x16 o[4];
#pragma unroll
  for (int d = 0; d < 4; ++d)
#pragma unroll
    for (int r = 0; r < 16; ++r) o[d][r] = 0.f;
  float m = -1e30f, lsum = 0.f;
  bf16x8 kr[KCH], vr[VCH];
#define ATT_LOADK(key0)                                                                                  \
  do {                                                                                                   \
    _Pragma("unroll") for (int i = 0; i < KCH; ++i) { int c = tid + NT * i; kr[i] = ld8(Kp + (long)((key0) + c / CPR) * DK + (c % CPR) * 8); } \
  } while (0)
#define ATT_LOADV(key0)                                                                                  \
  do {                                                                                                   \
    _Pragma("unroll") for (int i = 0; i < VCH; ++i) { int c = tid + NT * i; vr[i] = ld8(Vtp + (long)(c / VPR) * T + (key0) + (c % VPR) * 8); }  \
  } while (0)
  ATT_LOADK(0); ATT_LOADV(0);
  const int NTL = nkeys / KT;
  for (int j = 0; j < NTL; ++j) {
    __syncthreads();
#pragma unroll
    for (int i = 0; i < KCH; ++i) { int c = tid + NT * i; st8(Ks + (c / CPR) * LK + (c % CPR) * 8, kr[i]); }
#pragma unroll
    for (int i = 0; i < VCH; ++i) { int c = tid + NT * i; st8(Vs + (c / VPR) * LV + (c % VPR) * 8, vr[i]); }
    __syncthreads();
    if (j + 1 < NTL) ATT_LOADK((j + 1) * KT);
    f32x16 sv[NBK];
#pragma unroll
    for (int bk = 0; bk < NBK; ++bk)
#pragma unroll
      for (int r = 0; r < 16; ++r) sv[bk][r] = 0.f;
    const bfu* k0p = Ks + l32 * LK + hi * 8;
#pragma unroll
    for (int ks = 0; ks < NKS; ++ks)
#pragma unroll
      for (int bk = 0; bk < NBK; ++bk) sv[bk] = MFMA(ld8(k0p + bk * 32 * LK + ks * 16), qf[ks], sv[bk]);
    float mx = sv[0][0];
#pragma unroll
    for (int bk = 0; bk < NBK; ++bk)
#pragma unroll
      for (int r = 0; r < 16; ++r) mx = fmaxf(mx, sv[bk][r]);
    mx = fmaxf(mx, __shfl_xor(mx, 32));
    float mn = m, alpha = 1.f;
    const bool moved = __builtin_amdgcn_ballot_w64(mx > m + 8.f) != 0ull;
    if (moved) { mn = fmaxf(m, mx); alpha = __builtin_amdgcn_exp2f(m - mn); m = mn; }
    float rs = 0.f;
#pragma unroll
    for (int bk = 0; bk < NBK; ++bk)
#pragma unroll
      for (int r = 0; r < 16; ++r) { sv[bk][r] = __builtin_amdgcn_exp2f(sv[bk][r] - mn); rs += sv[bk][r]; }
    lsum = lsum * alpha + rs;
    if (moved) {
#pragma unroll
      for (int d = 0; d < 4; ++d)
#pragma unroll
        for (int r = 0; r < 16; ++r) o[d][r] *= alpha;
    }
    bf16x8 pf[2 * NBK];
#pragma unroll
    for (int bk = 0; bk < NBK; ++bk) { pf[2 * bk] = packacc(sv[bk], 0); pf[2 * bk + 1] = packacc(sv[bk], 1); }
    if (j + 1 < NTL) ATT_LOADV((j + 1) * KT);
#pragma unroll
    for (int kk = 0; kk < 2 * NBK; ++kk)
#pragma unroll
      for (int d = 0; d < 4; ++d) o[d] = MFMA(ld44(Vs + (d * 32 + l32) * LV + kk * 16 + 4 * hi), pf[kk], o[d]);
  }
#undef ATT_LOADK
#undef ATT_LOADV
  const float inv = 1.f / (lsum + __shfl_xor(lsum, 32));
  bfu* orow = Op + (long)(w * 32 + l32) * ldo;
#pragma unroll
  for (int d = 0; d < 4; ++d)
#pragma unroll
    for (int rg = 0; rg < 4; ++rg) {
      u32x2 v = {cvtpk(o[d][4 * rg] * inv, o[d][4 * rg + 1] * inv), cvtpk(o[d][4 * rg + 2] * inv, o[d][4 * rg + 3] * inv)};
      *reinterpret_cast<u32x2*>(orow + d * 32 + 8 * rg + 4 * hi) = v;
    }
}

template <bool ML>
DI void scan_block(const Params& p, int sitem, char* smem) {
  constexpr int DKS = ML ? 128 : 256, LQ = 136, LT = 72;
  char* G = OPQ(p.ws + WS_G);
  const int tid = TID(), lane = tid & 63, w = tid >> 6, l32 = lane & 31, hi = lane >> 5;
  int half = 0, dvg = 0, dir, head, bg; bool isden = false;
  if (ML) { const int which = sitem % 3, rest = sitem / 3; dir = rest & 1; head = (rest >> 1) & 7; bg = rest >> 4; isden = which == 2; dvg = isden ? 0 : which; }
  else { half = sitem & 1; dvg = (sitem >> 1) & 1; const int rest = sitem >> 2; dir = rest & 1; head = (rest >> 1) & 7; bg = rest >> 4; }
  const long hb = (long)(bg * 8 + head);
  const bfu* q = (const bfu*)(G + (ML ? L0_MQ : L1_RQ)) + hb * T * DKS + half * 128;
  const bfu* k = (const bfu*)(G + (ML ? L0_MK : L1_RK)) + hb * T * DKS + half * 128;
  const bfu* kT = (const bfu*)(G + (ML ? L0_MKT : L1_RKT)) + (hb * DKS + half * 128) * T;
  const bfu* vT = (const bfu*)(G + (ML ? L0_MVT : L1_RVT)) + (hb * 256 + dvg * 128) * T;
  const float* gbp = (const float*)(G + L0_SM + SM_GI) + ((long)(dir * GB + bg) * 8 + head) * T;
  const float* gsp = (const float*)(G + L0_SM + SM_GF) + ((long)(dir * GB + bg) * 8 + head) * T;
  const float* gcp = (const float*)(G + L0_SM + SM_GC) + ((long)(dir * GB + bg) * 8 + head) * T;
  float* dnp = (float*)(G + L0_SM + SM_DN) + ((long)(dir * GB + bg) * 8 + head) * T;
  bfu* outp = ML ? (bfu*)(G + L0_HN) + ((long)dir * MG + (long)bg * T) * 2048 + head * 256 + dvg * 128 + w * 32
                 : (bfu*)(G + L1_R) + ((long)(dir * 2 + half) * MG + (long)bg * T) * 2048 + head * 256 + dvg * 128 + w * 32;
  bfu* qS = (bfu*)smem; bfu* kS = qS + 64 * LQ; bfu* kTS = kS + 64 * LQ; bfu* vTS = kTS + 128 * LT; float* wsm = (float*)(vTS + 128 * LT);
  float lg2 = 0.f;
  if (!ML) lg2 = logsig(p.ret_decay()[dir * 8 + head]) * LOG2E;
  const bf16x8 ones = {0x3F80, 0x3F80, 0x3F80, 0x3F80, 0x3F80, 0x3F80, 0x3F80, 0x3F80};
  const bool active = !isden || w == 0;
  const int r16 = tid >> 4, c16 = (tid & 15) * 8, r8 = tid >> 3, c8 = (tid & 7) * 8;
  bf16x8 ra[4], rb[4];
  float bN = 0.f, gsN = 0.f, cmN = 0.f;
#define SC_LOAD_QK(p0_)                                                                                   \
  do {                                                                                                    \
    _Pragma("unroll") for (int i = 0; i < 4; ++i) {                                                       \
      ra[i] = ld8(q + (long)((p0_) + r16 + 16 * i) * DKS + c16); rb[i] = ld8(k + (long)((p0_) + r16 + 16 * i) * DKS + c16); \
    }                                                                                                     \
    if (ML && w == 0) { bN = gbp[(p0_) + lane]; gsN = gsp[(p0_) + lane]; cmN = gcp[(p0_) + lane]; }      \
  } while (0)
#define SC_STORE_QK()                                                                                     \
  _Pragma("unroll") for (int i = 0; i < 4; ++i) { st8(qS + (r16 + 16 * i) * LQ + c16, ra[i]); st8(kS + (r16 + 16 * i) * LQ + c16, rb[i]); }
#define SC_LOAD_T(p0_)                                                                                    \
  _Pragma("unroll") for (int i = 0; i < 4; ++i) {                                                         \
    ra[i] = ld8(kT + (long)(r8 + 32 * i) * T + (p0_) + c8);                                               \
    rb[i] = isden ? ones : ld8(vT + (long)(r8 + 32 * i) * T + (p0_) + c8);                                \
  }
#define SC_STORE_T()                                                                                      \
  _Pragma("unroll") for (int i = 0; i < 4; ++i) { st8(kTS + (r8 + 32 * i) * LT + c8, ra[i]); st8(vTS + (r8 + 32 * i) * LT + c8, rb[i]); }
#define SC_CHUNK(ci_) (dir == 0 ? (ci_) : ((ci_) < 4 ? 3 - (ci_) : 39 - (ci_)))
  __syncthreads();
  if (!ML && tid < 64) {
    wsm[128 + tid] = __builtin_amdgcn_exp2f(lg2 * (dir == 0 ? (float)(tid + 1) : (float)(64 - tid)));
    wsm[192 + tid] = __builtin_amdgcn_exp2f(lg2 * (dir == 0 ? (float)(63 - tid) : (float)tid));
    wsm[tid] = __builtin_amdgcn_exp2f(lg2 * (dir == 0 ? (float)tid : -(float)tid));
    wsm[64 + tid] = __builtin_amdgcn_exp2f(lg2 * (dir == 0 ? -(float)tid : (float)tid));
    if (tid == 0) wsm[320] = __builtin_amdgcn_exp2f(lg2 * 64.f);
  }
  SC_LOAD_QK(SC_CHUNK(0) * 64);
  SC_STORE_QK();
  SC_LOAD_T(SC_CHUNK(0) * 64);
  f32x16 C[4];
#pragma unroll
  for (int i = 0; i < 4; ++i)
#pragma unroll
    for (int r = 0; r < 16; ++r) C[i][r] = 0.f;
  float mst = 0.f;
  for (int ci = 0; ci < 36; ++ci) {
    const int p0 = SC_CHUNK(ci) * 64;
    __syncthreads();
    SC_STORE_T();
    const float b = bN, gs = gsN, cm = cmN;
    if (ci + 1 < 36) SC_LOAD_QK(SC_CHUNK(ci + 1) * 64);
    if (ML && w == 0) {
      const float bend = __uint_as_float(dir == 0 ? __builtin_amdgcn_readlane(__float_as_uint(b), 63) : __builtin_amdgcn_readlane(__float_as_uint(b), 0));
      const float gmx = __uint_as_float(dir == 0 ? __builtin_amdgcn_readlane(__float_as_uint(cm), 63) : __builtin_amdgcn_readlane(__float_as_uint(cm), 0));
      const float inter = b + mst, mt = fmaxf(b + cm, inter), a = __expf(inter - mt);
      const float mnew = fmaxf(bend + mst, bend + gmx);
      wsm[lane] = b - mt; wsm[64 + lane] = gs; wsm[128 + lane] = a; wsm[192 + lane] = __expf(bend + gs - mnew); wsm[256 + lane] = __expf(-mt);
      if (lane == 0) wsm[320] = __expf(bend + mst - mnew);
      mst = mnew;
    }
    __syncthreads();
    if (active) {
      const int tbx = dir == 0 ? 1 : 0, sbx = 1 - tbx;
      f32x16 out0, out1;
#pragma unroll
      for (int r = 0; r < 16; ++r) { out0[r] = 0.f; out1[r] = 0.f; }
      {
        const bfu* qa = qS + l32 * LQ + 4 * hi; const bfu* qb = qa + 32 * LQ;
#pragma unroll
        for (int i = 0; i < 4; ++i)
#pragma unroll
          for (int s2 = 0; s2 < 2; ++s2) {
            const bf16x8 cf = packacc(C[i], s2);
            out0 = MFMA(cf, ld44(qa + 32 * i + 16 * s2), out0);
            out1 = MFMA(cf, ld44(qb + 32 * i + 16 * s2), out1);
          }
      }
      {
        const float sct0 = wsm[128 + l32], sct1 = wsm[160 + l32];
#pragma unroll
        for (int r = 0; r < 16; ++r) { out0[r] *= sct0; out1[r] *= sct1; }
      }
      const bfu* v0 = vTS + (w * 32 + l32) * LT + 4 * hi; const bfu* v1 = v0 + 32;
      const float sB0 = wsm[l32], sB1 = wsm[32 + l32];
      {
        f32x16 sd0, sx;
#pragma unroll
        for (int r = 0; r < 16; ++r) { sd0[r] = 0.f; sx[r] = 0.f; }
        const bfu* k0 = kS + l32 * LQ + hi * 8; const bfu* kx = k0 + sbx * 32 * LQ;
        const bfu* q0 = qS + l32 * LQ + hi * 8; const bfu* qx = q0 + tbx * 32 * LQ;
#pragma unroll 2
        for (int ks = 0; ks < 8; ++ks) {
          sd0 = MFMA(ld8(k0 + ks * 16), ld8(q0 + ks * 16), sd0);
          sx = MFMA(ld8(kx + ks * 16), ld8(qx + ks * 16), sx);
        }
        const float sBx = tbx ? sB1 : sB0;
#pragma unroll
        for (int r = 0; r < 16; ++r) {
          const int sl = crow(r, hi);
          const bool valid = dir == 0 ? sl <= l32 : sl >= l32;
          float w0, wx;
          if (ML) { w0 = __expf(sB0 + wsm[64 + sl]); wx = __expf(sBx + wsm[64 + sbx * 32 + sl]); }
          else { w0 = sB0 * wsm[64 + sl]; wx = sBx * wsm[64 + sbx * 32 + sl]; }
          sd0[r] = valid ? sd0[r] * w0 : 0.f; sx[r] *= wx;
        }
#pragma unroll
        for (int s2 = 0; s2 < 2; ++s2) out0 = MFMA(ld44(v0 + 16 * s2), packacc(sd0, s2), out0);
        if (dir == 0) {
#pragma unroll
          for (int s2 = 0; s2 < 2; ++s2) out1 = MFMA(ld44(v0 + 16 * s2), packacc(sx, s2), out1);
        } else {
#pragma unroll
          for (int s2 = 0; s2 < 2; ++s2) out0 = MFMA(ld44(v1 + 16 * s2), packacc(sx, s2), out0);
        }
      }
      {
        f32x16 sa, sb_;
#pragma unroll
        for (int r = 0; r < 16; ++r) { sa[r] = 0.f; sb_[r] = 0.f; }
        const bfu* k1 = kS + (32 + l32) * LQ + hi * 8; const bfu* q1 = qS + (32 + l32) * LQ + hi * 8;
#pragma unroll 2
        for (int ks = 0; ks < 8; ks += 2) {
          sa = MFMA(ld8(k1 + ks * 16), ld8(q1 + ks * 16), sa);
          sb_ = MFMA(ld8(k1 + ks * 16 + 16), ld8(q1 + ks * 16 + 16), sb_);
        }
#pragma unroll
        for (int r = 0; r < 16; ++r) {
          const int sl = crow(r, hi);
          const bool valid = dir == 0 ? sl <= l32 : sl >= l32;
          float w1;
          if (ML) w1 = __expf(sB1 + wsm[96 + sl]);
          else w1 = sB1 * wsm[96 + sl];
          sa[r] = valid ? (sa[r] + sb_[r]) * w1 : 0.f;
        }
#pragma unroll
        for (int s2 = 0; s2 < 2; ++s2) out1 = MFMA(ld44(v1 + 16 * s2), packacc(sa, s2), out1);
      }
      if (!isden) {
        bfu* orow0 = outp + (long)(p0 + l32) * 2048; bfu* orow1 = orow0 + 32 * 2048;
#pragma unroll
        for (int rg = 0; rg < 4; ++rg) {
          u32x2 va = {cvtpk(out0[4 * rg], out0[4 * rg + 1]), cvtpk(out0[4 * rg + 2], out0[4 * rg + 3])};
          u32x2 vb = {cvtpk(out1[4 * rg], out1[4 * rg + 1]), cvtpk(out1[4 * rg + 2], out1[4 * rg + 3])};
          *reinterpret_cast<u32x2*>(orow0 + 8 * rg + 4 * hi) = va;
          *reinterpret_cast<u32x2*>(orow1 + 8 * rg + 4 * hi) = vb;
        }
      } else if (hi == 0) {
        dnp[p0 + l32] = fmaxf(fabsf(out0[0]), wsm[256 + l32]);
        dnp[p0 + 32 + l32] = fmaxf(fabsf(out1[0]), wsm[288 + l32]);
      }
    }
    __syncthreads();
    if (ci + 1 < 36) { SC_STORE_QK(); SC_LOAD_T(SC_CHUNK(ci + 1) * 64); }
    if (active) {
      const float decay = wsm[320];
#pragma unroll
      for (int i = 0; i < 4; ++i)
#pragma unroll
        for (int r = 0; r < 16; ++r) C[i][r] *= decay;
#pragma unroll
      for (int s4 = 0; s4 < 4; ++s4) {
        float vf[8];
        unpack8(ld8(vTS + (w * 32 + l32) * LT + s4 * 16 + hi * 8), vf);
#pragma unroll
        for (int j = 0; j < 8; ++j) {
          const int s = s4 * 16 + hi * 8 + j;
          vf[j] *= wsm[192 + s];
        }
        const bf16x8 bfr = pack8f(vf);
#pragma unroll
        for (int i = 0; i < 4; ++i) C[i] = MFMA(ld8(kTS + (32 * i + l32) * LT + s4 * 16 + hi * 8), bfr, C[i]);
      }
    }
  }
#undef SC_LOAD_QK
#undef SC_STORE_QK
#undef SC_LOAD_T
#undef SC_STORE_T
#undef SC_CHUNK
}

template <int layer, int part>
DI void phase_mix(const Params& p, int cidx, char* smem, int* s_item) {
  char* G = OPQ(p.ws + WS_G);
  const int tid = TID(), w = tid >> 6;
  const int xcd = blockIdx.x & 7;
  const int nscan_all = layer == 0 ? GB * 8 * 2 * 3 : GB * 8 * 2 * 4;
  const int nscan = part == 1 ? 0 : (nscan_all - xcd + 7) >> 3;
  const int natt = part == 0 ? 0 : (layer == 0 ? 8 * 18 : 4 * 16);
  int* ctr = P_CTR + (cidx + (part == 1 ? 16 : 0)) * 8 + xcd;
  int item;
#define NEXT_ITEM()                                             \
  do {                                                          \
    __syncthreads();                                            \
    if (tid == 0) *s_item = atomicAdd(ctr, 1);                  \
    __syncthreads();                                            \
    item = *s_item;                                             \
  } while (0)
  const int nsb = layer == 0 ? 12 : 16;
  const bool scanner = part != 1 && ((int)gridDim.x != 512 || (int)(blockIdx.x >> 3) < nsb);
  if (scanner || part != 0) NEXT_ITEM(); else item = 1 << 30;
  while (scanner && item < nscan) {
    const int sib = layer == 0 ? 3 : 4;
    const int sitem = (xcd + 8 * (item / sib)) * sib + item % sib;
    __builtin_amdgcn_s_setprio(3);
    if (layer == 0) scan_block<true>(p, sitem, smem);
    else scan_block<false>(p, sitem, smem);
    __builtin_amdgcn_s_setprio(0);
    NEXT_ITEM();
  }
  while (item < nscan + natt) {
    int a = item - nscan;
    if (layer == 0) {
      int pl, t0, nkeys;
      if (a < 128) { pl = a >> 4; t0 = CTX + (a & 15) * 128; nkeys = T; }
      else { a -= 128; pl = a >> 1; t0 = (a & 1) * 128; nkeys = CTX; }
      const int bh = (pl >> 1) * 8 + xcd, bg = bh >> 4, hv = (bh & 15) * 2 + (pl & 1);
      attn_item<64, 64>((const bfu*)(G + L0_QD) + ((long)(bg * 32 + hv) * T + t0) * 64, (const bfu*)(G + L0_KD) + (long)(bg * 32 + hv) * T * 64,
                    (const bfu*)(G + L0_VT) + (long)(bg * 16 + (hv >> 1)) * 128 * T, nkeys, (bfu*)(G + L0_OA) + ((long)bg * T + t0) * 4096 + hv * 128, 4096, smem);
    } else {
      const int pl = a >> 4, t0 = CTX + (a & 15) * 128;
      const int pair = pl * 8 + xcd, bg = pair >> 4, h = pair & 15;
      attn_item<192, 64>((const bfu*)(G + L1_Q) + ((long)(bg * 16 + h) * T + t0) * 192, (const bfu*)(G + L1_K) + (long)(bg * 16 + h) * T * 192,
                     (const bfu*)(G + L1_VT) + (long)(bg * 16 + h) * 128 * T, T, (bfu*)(G + L1_OA) + ((long)bg * T + t0) * 2048 + h * 128, 2048, smem);
    }
    NEXT_ITEM();
  }
#undef NEXT_ITEM
}

DI void phase_comb0(const Params& p, char* smem) {
  char* G = OPQ(p.ws + WS_G);
  const int tid = TID(), c0 = tid * 8;
  float* sl = (float*)smem;
  __syncthreads();
  if (tid < 64) {
    float a = wsum(p.diff_lam()[tid] * p.diff_lam()[64 + tid]), b = wsum(p.diff_lam()[128 + tid] * p.diff_lam()[192 + tid]);
    if (tid == 0) sl[0] = __expf(a) - __expf(b) + 0.2f;
  }
  __syncthreads();
  const float lam = sl[0];
  const bfu* Oa = (const bfu*)(G + L0_OA); const bfu* Hn = (const bfu*)(G + L0_HN); const bfu* og = (const bfu*)(G + L0_OG);
  const bfu* gate = (const bfu*)(G + L0_GATE); const float* dn = (const float*)(G + L0_SM + SM_DN); bfu* mix = (bfu*)(G + L0_MIX);
  float gd[8], gm[8];
  for (int j = 0; j < 8; ++j) { gd[j] = p.diff_g()[c0 + j]; gm[j] = p.mlstm_g()[c0 + j]; }
  for (int i = blockIdx.x; i < MG; i += gridDim.x) {
    const int bg = i / T, t = i % T;
    const bf16x8 r_o1 = ld8(Oa + (long)i * 4096 + ((c0 >> 7) * 2) * 128 + (c0 & 127)), r_o2 = ld8(Oa + (long)i * 4096 + ((c0 >> 7) * 2 + 1) * 128 + (c0 & 127));
    const bf16x8 r_g0 = ld8(gate + (long)i * 4096 + c0), r_g1 = ld8(gate + (long)i * 4096 + 2048 + c0);
    const bf16x8 r_h0 = ld8(Hn + (long)i * 2048 + c0), r_h1 = ld8(Hn + ((long)MG + i) * 2048 + c0), r_og = ld8(og + (long)i * 2048 + c0);
    const float r_d0 = dn[((long)(0 * GB + bg) * 8 + (c0 >> 8)) * T + t], r_d1 = dn[((long)(1 * GB + bg) * 8 + (c0 >> 8)) * T + t];
    float o[8];
    {
      float o1[8], o2[8], gt[8];
      unpack8(r_o1, o1); unpack8(r_o2, o2);
      unpack8(r_g0, gt);
      float ss = 0;
      for (int j = 0; j < 8; ++j) { o1[j] -= lam * o2[j]; ss += o1[j] * o1[j]; }
      ss += __shfl_xor(ss, 1); ss += __shfl_xor(ss, 2); ss += __shfl_xor(ss, 4); ss += __shfl_xor(ss, 8);
      const float rms = rsqrtf(ss * (1.f / 128.f) + EPS) * 0.8f;
      for (int j = 0; j < 8; ++j) o[j] = o1[j] * rms * gd[j] * silu(gt[j]);
      st8(mix + (long)i * 4096 + c0, pack8f(o));
    }
    {
      float h0[8], h1[8], gt[8], ov[8];
      unpack8(r_h0, h0); unpack8(r_h1, h1);
      unpack8(r_g1, gt); unpack8(r_og, ov);
      const float d0 = 1.f / r_d0, d1 = 1.f / r_d1;
      float sm = 0;
      for (int j = 0; j < 8; ++j) { h0[j] = h0[j] * d0 + h1[j] * d1; sm += h0[j]; }
      sm += __shfl_xor(sm, 1); sm += __shfl_xor(sm, 2); sm += __shfl_xor(sm, 4); sm += __shfl_xor(sm, 8); sm += __shfl_xor(sm, 16);
      const float mean = sm * (1.f / 256.f);
      float sq = 0;
      for (int j = 0; j < 8; ++j) { h0[j] -= mean; sq += h0[j] * h0[j]; }
      sq += __shfl_xor(sq, 1); sq += __shfl_xor(sq, 2); sq += __shfl_xor(sq, 4); sq += __shfl_xor(sq, 8); sq += __shfl_xor(sq, 16);
      const float rstd = rsqrtf(sq * (1.f / 256.f) + EPS);
      for (int j = 0; j < 8; ++j) o[j] = h0[j] * rstd * gm[j] * sigm(ov[j]) * silu(gt[j]);
      st8(mix + (long)i * 4096 + 2048 + c0, pack8f(o));
    }
  }
}
DI void phase_comb1(const Params& p) {
  char* G = OPQ(p.ws + WS_G);
  const int tid = TID(), c0 = tid * 8;
  const bfu* Oa = (const bfu*)(G + L1_OA); const bfu* R = (const bfu*)(G + L1_R); const bfu* gate = (const bfu*)(G + L1_GATE); bfu* mix = (bfu*)(G + L1_MIX);
  float gr[8];
  for (int j = 0; j < 8; ++j) gr[j] = p.ret_g()[c0 + j];
  for (int i = blockIdx.x; i < MG; i += gridDim.x) {
    if ((i % T) < CTX) continue;
    const bf16x8 r0 = ld8(R + (long)i * 2048 + c0), r1 = ld8(R + ((long)MG + i) * 2048 + c0), r2 = ld8(R + ((long)2 * MG + i) * 2048 + c0), r3 = ld8(R + ((long)3 * MG + i) * 2048 + c0);
    const bf16x8 rg0 = ld8(gate + (long)i * 4096 + c0), rg1 = ld8(gate + (long)i * 4096 + 2048 + c0), roa = ld8(Oa + (long)i * 2048 + c0);
    float o[8];
    {
      float h0[8], h1[8], gt[8];
      float h2[8], h3[8];
      unpack8(r0, h0); unpack8(r1, h1);
      unpack8(r2, h2); unpack8(r3, h3); unpack8(rg0, gt);
      float sm = 0;
      for (int j = 0; j < 8; ++j) { h0[j] = (h0[j] + h1[j]) + (h2[j] + h3[j]); sm += h0[j]; }
      sm += __shfl_xor(sm, 1); sm += __shfl_xor(sm, 2); sm += __shfl_xor(sm, 4); sm += __shfl_xor(sm, 8); sm += __shfl_xor(sm, 16);
      const float mean = sm * (1.f / 256.f);
      float sq = 0;
      for (int j = 0; j < 8; ++j) { h0[j] -= mean; sq += h0[j] * h0[j]; }
      sq += __shfl_xor(sq, 1); sq += __shfl_xor(sq, 2); sq += __shfl_xor(sq, 4); sq += __shfl_xor(sq, 8); sq += __shfl_xor(sq, 16);
      const float rstd = rsqrtf(sq * (1.f / 256.f) + EPS);
      for (int j = 0; j < 8; ++j) o[j] = h0[j] * rstd * gr[j] * silu(gt[j]);
      st8(mix + (long)i * 4096 + c0, pack8f(o));
    }
    {
      float a[8], gt[8];
      unpack8(roa, a); unpack8(rg1, gt);
      for (int j = 0; j < 8; ++j) o[j] = a[j] * silu(gt[j]);
      st8(mix + (long)i * 4096 + 2048 + c0, pack8f(o));
    }
  }
}

template <int OP, int LAYER>
__global__ void __launch_bounds__(NT) phase_kernel(KArgs ka, int g) {
  __shared__ __attribute__((aligned(16))) char smem[SMEM_BYTES];
  __shared__ float rsl[128];
  __shared__ int s_item;
  __shared__ unsigned long long s_ptrs[24];
  if (threadIdx.x < 22) s_ptrs[threadIdx.x] = (unsigned long long)ka.in[threadIdx.x];
  __syncthreads();
  Params p; p.sp = s_ptrs; p.out = ka.out; p.ws = ka.ws;
  if (OP == 0) phase_prep0(p, smem);
  else if (OP == 1) phase_mod(p, g, LAYER, smem);
  else if (OP == 2) phase_gemm(p, g, LAYER, smem, rsl, &s_item, 0, LAYER == 0 ? 65 : 44, 0);
  else if (OP == 3) phase_gemm(p, g, 2, smem, rsl, &s_item, 0, 28, 1);
  else if (OP == 4) phase_mix<LAYER, 2>(p, LAYER * 8 + g, smem, &s_item);
  else if (OP == 5) { if (LAYER == 0) phase_comb0(p, smem); else phase_comb1(p); }
  else if (OP == 6) phase_gemm(p, g, 3 + LAYER, smem, rsl, &s_item, 0, 8, 2);
  else if (OP == 7) phase_prep1(p, smem);
  else phase_final(p, smem);
}

#if !MULTI
#define XB_TMO      128
#define XB_XCNT(j)  (256  + 64 * (j))
#define XB_XSUB(j)  (1280 + 64 * (j))
#define XB_XGEN(j)  (2304 + 64 * (j))
#define XB_TOP      3328
#define XB_TOPGEN   3392
#define XCD_BAR_WORDS 3456
#define XB_SPIN_CAP (1u << 18)
#define LAS __attribute__((address_space(3)))

__device__ __forceinline__ unsigned xb_ld(unsigned* p)              { return __hip_atomic_load(p, __ATOMIC_RELAXED, __HIP_MEMORY_SCOPE_AGENT); }
__device__ __forceinline__ unsigned xb_add(unsigned* p, unsigned v) { return __hip_atomic_fetch_add(p, v, __ATOMIC_RELAXED, __HIP_MEMORY_SCOPE_AGENT); }
__device__ __forceinline__ unsigned xb_xcc_id() { return (unsigned)__builtin_amdgcn_s_getreg((3 << 11) | 20) & 0xFu; }
#define XB_SPIN(cond, bar) do { unsigned _sp = 0; while (cond) { __builtin_amdgcn_s_sleep(1); \
    if ((++_sp & 255u) == 0u) { if (xb_ld(&(bar)[XB_TMO])) break; if (_sp > XB_SPIN_CAP) { atomicAdd(&(bar)[XB_TMO], 1u); break; } } } } while (0)

struct XcdBarrier {
    unsigned* bar; unsigned x;
    volatile LAS unsigned* st;
};

__device__ __forceinline__ XcdBarrier xcd_barrier_post(unsigned* bar, volatile LAS unsigned* st) {
    XcdBarrier b; b.bar = bar; b.x = xb_xcc_id(); b.st = st;
    if (threadIdx.x == 0) (void)xb_add(&bar[XB_XCNT(b.x)], 1u);
    return b;
}
__device__ __forceinline__ void xcd_barrier_complete(unsigned* bar, unsigned x, unsigned& nloc, unsigned& nx) {
    const unsigned G = gridDim.x * gridDim.y * gridDim.z;
    unsigned sum, cnt, mine, sp = 0u;
    for (;;) {
        sum = 0u; cnt = 0u; mine = 0u;
#pragma unroll
        for (unsigned j = 0; j < 16; ++j) { const unsigned c = xb_ld(&bar[XB_XCNT(j)]); sum += c; cnt += (c > 0u) ? 1u : 0u; mine = (j == x) ? c : mine; }
        if (sum == G) break;
        __builtin_amdgcn_s_sleep(1);
        if ((++sp & 255u) == 0u) { if (xb_ld(&bar[XB_TMO])) break; if (sp > XB_SPIN_CAP) { atomicAdd(&bar[XB_TMO], 1u); break; } }
    }
    nloc = mine > 0u ? mine : 1u; nx = cnt > 0u ? cnt : 1u;
}

__device__ __forceinline__ void xcd_barrier(const XcdBarrier& b) {
    asm volatile("s_waitcnt vmcnt(0)" ::: "memory");
    __syncthreads();
    if (threadIdx.x == 0) {
        unsigned* bar = b.bar;
        __builtin_amdgcn_s_waitcnt(0);
        unsigned nloc = b.st[0], nx = b.st[1];
        if (nloc == 0u) { xcd_barrier_complete(bar, b.x, nloc, nx); b.st[0] = nloc; b.st[1] = nx; }
        const unsigned old = xb_add(&bar[XB_XSUB(b.x)], 1u);
        const unsigned gen = old / nloc;
        if (old + 1u == (gen + 1u) * nloc) {
            __builtin_amdgcn_fence(__ATOMIC_RELEASE, "agent");
            asm volatile("s_waitcnt vmcnt(0)" ::: "memory");
            const unsigned og = xb_add(&bar[XB_TOP], 1u);
            const unsigned tg = og / nx;
            if (og + 1u == (tg + 1u) * nx) xb_add(&bar[XB_TOPGEN], 1u);
            else XB_SPIN(xb_ld(&bar[XB_TOPGEN]) == tg, bar);
            __builtin_amdgcn_fence(__ATOMIC_ACQUIRE, "agent");
            xb_add(&bar[XB_XGEN(b.x)], 1u);
            asm volatile("s_waitcnt vmcnt(0)" ::: "memory");
        } else {
            XB_SPIN(xb_ld(&bar[XB_XGEN(b.x)]) == gen, bar);
            __builtin_amdgcn_fence(__ATOMIC_ACQUIRE, "agent");
            asm volatile("s_waitcnt vmcnt(0)" ::: "memory");
        }
    }
    __syncthreads();
}


__global__ void __launch_bounds__(NT, 2) mega(KArgs ka) {
  __shared__ __attribute__((aligned(16))) char smem[SMEM_BYTES];
  __shared__ float rsl[128];
  __shared__ int s_item;
  __shared__ unsigned long long s_ptrs[24];
  if (threadIdx.x < 22) s_ptrs[threadIdx.x] = (unsigned long long)ka.in[threadIdx.x];
  __syncthreads();
  Params p; p.sp = s_ptrs; p.out = ka.out; p.ws = ka.ws;
  cg::grid_group grid = cg::this_grid();
  __shared__ uint4 xb_words;
  if (threadIdx.x == 0) xb_words = make_uint4(0u, 0u, 0u, 0u);
  __syncthreads();
  {
    const XcdBarrier xb0 = xcd_barrier_post((unsigned*)(ka.ws + WS_BAR), (volatile LAS unsigned*)&xb_words);
    if (threadIdx.x == 0) xb_words.z = xb0.x;
  }
  __syncthreads();
#ifndef REPG
#define REPG 1
#endif
#ifndef REPM
#define REPM 1
#endif
#ifndef REPE
#define REPE 1
#endif
#ifndef REPS
#define REPS 1
#endif
#define GSYNC() for (int rs_ = 0; rs_ < REPS; ++rs_) { XcdBarrier xb; xb.bar = (unsigned*)(OPQ(p.ws) + WS_BAR); xb.st = (volatile LAS unsigned*)&xb_words; xb.x = xb.st[2]; xcd_barrier(xb); }
  for (int r_ = 0; r_ < REPE; ++r_) phase_prep0(p, smem);
  if (ka.ws == nullptr) grid.sync();
  GSYNC();
  phase_mod(p, 0, 0, smem);
  GSYNC();
  phase_gemm(p, 0, 0, smem, rsl, &s_item, 0, 28, 0);
  GSYNC();
  for (int g = 0; g < NG; ++g) {
    phase_mix<0, 0>(p, g, smem, &s_item);
    phase_gemm(p, g, 0, smem, rsl, &s_item, 28, 65, 1);
    GSYNC();
    phase_mix<0, 1>(p, g, smem, &s_item);
    GSYNC();
    phase_comb0(p, smem);
    if (g + 1 < NG) phase_mod(p, g + 1, 0, smem);
    GSYNC();
    phase_gemm(p, g, 3, smem, rsl, &s_item, 0, 8, 2);
    if (g + 1 < NG) phase_gemm(p, g + 1, 0, smem, rsl, &s_item, 0, 28, 0);
    else { phase_prep1(p, smem); phase_mod(p, 0, 1, smem); }
    GSYNC();
  }
  for (int g = 0; g < NG; ++g) {
    phase_gemm(p, g, 1, smem, rsl, &s_item, 0, 28, 3);
    GSYNC();
    phase_mix<1, 0>(p, 8 + g, smem, &s_item);
    phase_gemm(p, g, 1, smem, rsl, &s_item, 28, 44, 4);
    phase_gemm(p, g, 2, smem, rsl, &s_item, 0, 28, 5);
    GSYNC();
    phase_mix<1, 1>(p, 8 + g, smem, &s_item);
    GSYNC();
    phase_comb1(p);
    GSYNC();
    phase_gemm(p, g, 4, smem, rsl, &s_item, 0, 8, 6);
    if (g + 1 < NG) phase_mod(p, g + 1, 1, smem);
    GSYNC();
  }
  phase_final(p, smem);
}

#endif

extern "C" void kernel_launch(void* const* d_in, const int* in_sizes, int n_in, void* d_out, int out_size, void* d_ws, size_t ws_size, hipStream_t stream) {
  static int grid_blocks = 0;
  if (!grid_blocks) {
    int dev = 0, cus = 0, per_cu = 0;
    hipGetDevice(&dev);
    hipDeviceGetAttribute(&cus, hipDeviceAttributeMultiprocessorCount, dev);
#if !MULTI
    hipOccupancyMaxActiveBlocksPerMultiprocessor(&per_cu, mega, NT, 0);
#else
    per_cu = 2;
#endif
    if (per_cu > 2) per_cu = 2;
    grid_blocks = (cus * per_cu / 8) * 8;
    if (ws_size < WS_END) fprintf(stderr, "kernel_launch: workspace too small: %zu < %zu\n", ws_size, (size_t)WS_END);
  }
  if (ws_size < WS_END || grid_blocks <= 0) return;
  KArgs p{};
  for (int i = 0; i < 22; ++i) p.in[i] = (const float*)d_in[i];
  p.out = (float*)d_out;
  p.ws = (char*)d_ws;
#if MULTI
  const int GRD = 512;
#define LAUNCH(OP, LY, g) hipLaunchKernelGGL((phase_kernel<OP, LY>), dim3(GRD), dim3(NT), 0, stream, p, g)
  LAUNCH(0, 0, 0);
  for (int g = 0; g < NG; ++g) { LAUNCH(1, 0, g); LAUNCH(2, 0, g); LAUNCH(4, 0, g); LAUNCH(5, 0, g); LAUNCH(6, 0, g); }
  LAUNCH(7, 0, 0);
  for (int g = 0; g < NG; ++g) { LAUNCH(1, 1, g); LAUNCH(2, 1, g); LAUNCH(3, 1, g); LAUNCH(4, 1, g); LAUNCH(5, 1, g); LAUNCH(6, 1, g); }
  LAUNCH(8, 0, 0);
#else
  (void)hipMemsetAsync((char*)d_ws + WS_CTR, 0, 4096 + 16384, stream);
  void* args[] = {&p};
  hipError_t e = hipLaunchCooperativeKernel((void*)mega, dim3(grid_blocks), dim3(NT), args, 0, stream);
  if (e != hipSuccess) fprintf(stderr, "cooperative launch failed: %s (grid %d)\n", hipGetErrorString(e), grid_blocks);
#endif
}
```

```cpp
#include <hip/hip_runtime.h>
#include <hip/hip_cooperative_groups.h>
#include <cstdio>
#include <cstdint>
namespace cg = cooperative_groups;
#ifndef MULTI
#define MULTI 0
#endif

#define DI __device__ __forceinline__
typedef unsigned short bfu;
typedef __attribute__((ext_vector_type(8))) short bf16x8;
typedef __attribute__((ext_vector_type(4))) short bf16x4;
typedef __attribute__((ext_vector_type(16))) float f32x16;
typedef __attribute__((ext_vector_type(4))) float f32x4;
typedef __attribute__((ext_vector_type(4))) unsigned u32x4;
typedef __attribute__((ext_vector_type(2))) unsigned u32x2;
#define MFMA(a, b, c) __builtin_amdgcn_mfma_f32_32x32x16_bf16((a), (b), (c), 0, 0, 0)

constexpr int NB = 8, SEQ = 2048, CTX = 256, T = 2304, DM = 2048, MROWS = NB * T;
constexpr int GB = 2, NG = 4, MG = GB * T;
constexpr int N1 = 16512, N2 = 11136;
constexpr float LOG2E = 1.4426950408889634f;
constexpr float EPS = 1e-5f;
constexpr float ALPHA = 1.4142135623730951f;
constexpr int NT = 256;
constexpr int BK = 64, LDT = BK + 8;
constexpr int SMEM_BYTES = 2 * 2 * 128 * LDT * 2;
constexpr int CLD = 132;

struct KArgs { const float* in[22]; float* out; char* ws; };
struct Params {
  const unsigned long long* sp;
  float* out;
  char* ws;
  DI const float* x() const { return (const float*)sp[0]; }
  DI const float* c() const { return (const float*)sp[1]; }
  DI const float* ctx() const { return (const float*)sp[2]; }
  DI const float* c_ctx() const { return (const float*)sp[3]; }
  DI const float* ada_w() const { return (const float*)sp[4]; }
  DI const float* ada_b() const { return (const float*)sp[5]; }
  DI const float* ln_g() const { return (const float*)sp[6]; }
  DI const float* ln_b() const { return (const float*)sp[7]; }
  DI const float* ab_w_in() const { return (const float*)sp[8]; }
  DI const float* ab_b_if() const { return (const float*)sp[9]; }
  DI const float* diff_lam() const { return (const float*)sp[10]; }
  DI const float* diff_g() const { return (const float*)sp[11]; }
  DI const float* mlstm_g() const { return (const float*)sp[12]; }
  DI const float* ab_w_out() const { return (const float*)sp[13]; }
  DI const float* cd_w_in() const { return (const float*)sp[14]; }
  DI const float* ret_decay() const { return (const float*)sp[15]; }
  DI const float* ret_g() const { return (const float*)sp[16]; }
  DI const float* q_norm_g() const { return (const float*)sp[17]; }
  DI const float* w_uq() const { return (const float*)sp[18]; }
  DI const float* kv_norm_g() const { return (const float*)sp[19]; }
  DI const float* w_ukv() const { return (const float*)sp[20]; }
  DI const float* cd_w_out() const { return (const float*)sp[21]; }
};

constexpr size_t U = (size_t)MG * 2048 * 2;
constexpr size_t L0_QD = 0, L0_KD = U, L0_VT = 2 * U, L0_MQ = 3 * U, L0_MK = 3 * U + U / 2, L0_MKT = 4 * U, L0_MVT = 4 * U + U / 2,
                 L0_OG = 5 * U + U / 2, L0_GATE = 6 * U + U / 2, L0_OA = 8 * U + U / 2, L0_HN = 10 * U + U / 2, L0_SM = 12 * U + U / 2;
constexpr size_t L0_H = 13 * U, L0_MIX = 14 * U;
constexpr size_t L1_RQ = 0, L1_RK = U, L1_RKT = 2 * U, L1_RVT = 3 * U, L1_GATE = 4 * U, L1_Q = 6 * U, L1_K = 7 * U + U / 2, L1_VT = 9 * U,
                 L1_OA = 10 * U, L1_R = 11 * U, L1_QL = 15 * U, L1_KVL = 15 * U + U / 4, L1_SM = 15 * U + U / 2;
constexpr size_t L1_MIX = L1_RQ, L1_H = L1_OA;
constexpr size_t GREGION = 16 * U;
constexpr size_t SM_GI = 0, SM_GF = 2 * GB * 8 * T * 4, SM_DN = 2 * SM_GF, SM_SSQ = 3 * SM_GF, SM_SSK = SM_SSQ + (size_t)MG * 4 * 4, SM_GC = SM_SSK + (size_t)MG * 2 * 4;

constexpr size_t WS_ZX = 0;
constexpr size_t WS_WA = WS_ZX + (size_t)MROWS * 2048 * 4;
constexpr size_t WS_WO1 = WS_WA + (size_t)N1 * 2048 * 2;
constexpr size_t WS_MOD = WS_WO1 + (size_t)2048 * 4096 * 2;
constexpr size_t WS_CS64 = WS_MOD + 2 * 9 * 6144 * 4;
constexpr size_t WS_CS256 = WS_CS64 + 2048 * 32 * 2 * 4;
constexpr size_t WS_CTR = WS_CS256 + 2048 * 128 * 2 * 4;
constexpr size_t WS_BAR = WS_CTR + 4096;
constexpr size_t WS_G = WS_BAR + 16384;
constexpr size_t WS_END = WS_G + GREGION;
#define P_ZX ((float*)(p.ws + WS_ZX))
#define P_WA ((bfu*)(p.ws + WS_WA))
#define P_WO1 ((bfu*)(p.ws + WS_WO1))
#define P_MOD ((float*)(p.ws + WS_MOD))
#define P_CS64 ((float*)(p.ws + WS_CS64))
#define P_CS256 ((float*)(p.ws + WS_CS256))
#define P_CTR ((int*)(p.ws + WS_CTR))
constexpr size_t WA_W2 = 0, WA_WO2 = (size_t)N2 * 2048 * 2, WA_UQ = WA_WO2 + (size_t)2048 * 4096 * 2, WA_UKV = WA_UQ + (size_t)3072 * 512 * 2;

DI int TID() { int t = threadIdx.x; asm volatile("" : "+v"(t)); return t; }
DI char* OPQ(const void* ptr) { unsigned long long v = (unsigned long long)ptr; asm volatile("" : "+s"(v)); return (char*)v; }
DI int crow(int r, int hi) { return (r & 3) + 8 * (r >> 2) + 4 * hi; }
typedef __attribute__((ext_vector_type(2))) __bf16 bf16x2_t;
typedef __attribute__((ext_vector_type(2))) float f32x2_t;
DI unsigned cvtpk(float lo, float hi) { f32x2_t v = {lo, hi}; bf16x2_t b = __builtin_convertvector(v, bf16x2_t); return __builtin_bit_cast(unsigned, b); }
DI float bf2f(bfu v) { return __uint_as_float((unsigned)v << 16); }
DI float bflo(unsigned v) { return __uint_as_float(v << 16); }
DI float bfhi(unsigned v) { return __uint_as_float(v & 0xffff0000u); }
DI bf16x8 pack8f(const float* v) { u32x4 w = {cvtpk(v[0], v[1]), cvtpk(v[2], v[3]), cvtpk(v[4], v[5]), cvtpk(v[6], v[7])}; return __builtin_bit_cast(bf16x8, w); }
DI bf16x8 packacc(const f32x16& x, int s) {
  u32x4 w = {cvtpk(x[8 * s], x[8 * s + 1]), cvtpk(x[8 * s + 2], x[8 * s + 3]), cvtpk(x[8 * s + 4], x[8 * s + 5]), cvtpk(x[8 * s + 6], x[8 * s + 7])};
  return __builtin_bit_cast(bf16x8, w);
}
DI bf16x8 ld8(const bfu* p) { return *reinterpret_cast<const bf16x8*>(p); }
DI bf16x8 ld44(const bfu* p) {
  u32x2 a = *reinterpret_cast<const u32x2*>(p), b = *reinterpret_cast<const u32x2*>(p + 8);
  u32x4 w = {a[0], a[1], b[0], b[1]}; return __builtin_bit_cast(bf16x8, w);
}
DI void st8(bfu* p, bf16x8 v) { *reinterpret_cast<bf16x8*>(p) = v; }
DI void unpack8(bf16x8 v, float* f) { u32x4 w = __builtin_bit_cast(u32x4, v); for (int i = 0; i < 4; ++i) { f[2 * i] = bflo(w[i]); f[2 * i + 1] = bfhi(w[i]); } }
DI float silu(float v) { return v / (1.f + __expf(-v)); }
DI float sigm(float v) { return 1.f / (1.f + __expf(-v)); }
DI float logsig(float v) { return fminf(v, 0.f) - log1pf(__expf(-fabsf(v))); }
DI float wsum(float v) { for (int o = 32; o > 0; o >>= 1) v += __shfl_xor(v, o); return v; }
DI float wmax(float v) { for (int o = 32; o > 0; o >>= 1) v = fmaxf(v, __shfl_xor(v, o)); return v; }
DI float block_sum(float v, float* red) {
  v = wsum(v);
  __syncthreads();
  if ((TID() & 63) == 0) red[TID() >> 6] = v;
  __syncthreads();
  return red[0] + red[1] + red[2] + red[3];
}

DI int srccol1(int n) { return n < 12288 ? n : (n < 16384 ? n + 32 : (n < 16416 ? n - 4096 : -1)); }
DI int srccol2(int n) {
  if (n < 4096) { int base = n & ~255, j = n & 255, grp = j >> 6, w = j & 63; return base + (grp & 1) * 128 + (grp >> 1) * 64 + w; }
  if (n < 6976) return n;
  if (n < 7040) return -1;
  return n - 64;
}
DI void tr_load(const float* __restrict__ src, int ld, int K, int mapid, const float* __restrict__ ks, int tile, f32x4 (&v)[4]) {
  const int tid = TID();
  const int kT = K >> 6, nt = tile / kT, kt = tile % kT, n0 = nt * 64, k0 = kt * 64;
  const int n4 = (tid & 15) * 4, kr = tid >> 4;
  const int n = n0 + n4;
  const int sc = mapid == 1 ? srccol1(n) : (mapid == 2 ? srccol2(n) : n);
#pragma unroll
  for (int i = 0; i < 4; ++i) {
    const int k = i * 16 + kr;
    f32x4 x = {0.f, 0.f, 0.f, 0.f};
    if (sc >= 0) x = *reinterpret_cast<const f32x4*>(src + (long)(k0 + k) * ld + sc);
    if (ks) { const float g_ = ks[k0 + k]; x *= g_; }
    v[i] = x;
  }
}
DI void tr_finish(int K, bfu* __restrict__ dst, int tile, const f32x4 (&v)[4], float* tl) {
  const int tid = TID();
  const int kT = K >> 6, nt = tile / kT, kt = tile % kT, n0 = nt * 64, k0 = kt * 64;
  const int n4 = (tid & 15) * 4, kr = tid >> 4;
  __syncthreads();
#pragma unroll
  for (int i = 0; i < 4; ++i) {
    const int k = i * 16 + kr;
    tl[k * 65 + n4] = v[i][0]; tl[k * 65 + n4 + 1] = v[i][1]; tl[k * 65 + n4 + 2] = v[i][2]; tl[k * 65 + n4 + 3] = v[i][3];
  }
  __syncthreads();
  for (int i = 0; i < 2; ++i) {
    int n = i * 32 + (tid >> 3), k8 = (tid & 7) * 8;
    float o[8];
    for (int j = 0; j < 8; ++j) o[j] = tl[(k8 + j) * 65 + n];
    st8(dst + (long)(n0 + n) * K + k0 + k8, pack8f(o));
  }
}

DI void phase_prep0(const Params& p, char* smem) {
  float* tl = (float*)smem;
  const int tid = TID(), G_ = gridDim.x, b = blockIdx.x;
  if (b < 192) {
    for (int i = tid; i < 9 * 2048; i += NT) { const int r = i >> 11, k = i & 2047; tl[i] = silu(r < 8 ? p.c()[r * 2048 + k] : p.c_ctx()[k]); }
    __syncthreads();
    for (int it = b; it < 192; it += G_) {
      const int layer = it / 96, cg_ = it % 96, col = cg_ * 64 + (tid & 63), kq = tid >> 6;
      const float* w = p.ada_w() + (long)layer * 2048 * 6144 + col;
      float acc[9];
      for (int r = 0; r < 9; ++r) acc[r] = 0.f;
#pragma unroll 16
      for (int k = kq * 512; k < kq * 512 + 512; ++k) {
        const float wv = w[(long)k * 6144];
#pragma unroll
        for (int r = 0; r < 9; ++r) acc[r] += tl[r * 2048 + k] * wv;
      }
      __syncthreads();
      float* red = tl;
      for (int r = 0; r < 9; ++r) red[(kq * 9 + r) * 64 + (tid & 63)] = acc[r];
      __syncthreads();
      if (tid < 64) {
        for (int r = 0; r < 9; ++r) {
          float sm = red[r * 64 + tid] + red[(9 + r) * 64 + tid] + red[(18 + r) * 64 + tid] + red[(27 + r) * 64 + tid];
          P_MOD[((long)layer * 9 + r) * 6144 + col] = sm + p.ada_b()[layer * 6144 + col];
        }
      }
      __syncthreads();
    }
  }
  for (int i = b * NT + tid; i < 2048 * 160; i += G_ * NT) {
    int pos = i / 160, j = i % 160;
    float row = (float)(pos >> 6), col = (float)(pos & 63);
    if (j < 32) {
      int f = j & 15; float inv = powf(10000.f, -(float)f / 16.f); float ang = (j < 16 ? row : col) * inv;
      P_CS64[(pos * 32 + j) * 2] = cosf(ang); P_CS64[(pos * 32 + j) * 2 + 1] = sinf(ang);
    } else {
      int jj = j - 32, f = jj & 63; float inv = powf(10000.f, -(float)f / 64.f); float ang = (jj < 64 ? row : col) * inv;
      P_CS256[(pos * 128 + jj) * 2] = cosf(ang); P_CS256[(pos * 128 + jj) * 2 + 1] = sinf(ang);
    }
  }
  const int t1 = (N1 / 64) * 32, t2 = 32 * 64;
  {
    auto ld_ = [&](int it, f32x4 (&v)[4]) {
      if (it < t1) tr_load(p.ab_w_in(), 16416, 2048, 1, nullptr, it, v);
      else tr_load(p.ab_w_out(), 2048, 4096, 0, nullptr, it - t1, v);
    };
    auto fin_ = [&](int it, const f32x4 (&v)[4]) {
      if (it < t1) tr_finish(2048, P_WA, it, v, tl);
      else tr_finish(4096, P_WO1, it - t1, v, tl);
    };
    f32x4 va[4], vb[4];
    int it = b;
    if (it < t1 + t2) ld_(it, va);
    while (it < t1 + t2) {
      const int nx = it + G_;
      if (nx < t1 + t2) ld_(nx, vb);
      fin_(it, va);
#pragma unroll
      for (int i = 0; i < 4; ++i) va[i] = vb[i];
      it = nx;
    }
  }
}
DI void phase_prep1(const Params& p, char* smem) {
  float* tl = (float*)smem;
  const int G_ = gridDim.x, b = blockIdx.x;
  const int t1 = (N2 / 64) * 32, t2 = 32 * 64, t3 = 48 * 8, t4 = 64 * 4;
  bfu* wa = P_WA;
  {
    const int tot = t1 + t2 + t3 + t4;
    auto ld_ = [&](int it, f32x4 (&v)[4]) {
      if (it < t1) tr_load(p.cd_w_in(), 11072, 2048, 2, nullptr, it, v);
      else if (it < t1 + t2) tr_load(p.cd_w_out(), 2048, 4096, 0, nullptr, it - t1, v);
      else if (it < t1 + t2 + t3) tr_load(p.w_uq(), 3072, 512, 0, p.q_norm_g(), it - t1 - t2, v);
      else tr_load(p.w_ukv(), 4096, 256, 0, p.kv_norm_g(), it - t1 - t2 - t3, v);
    };
    auto fin_ = [&](int it, const f32x4 (&v)[4]) {
      if (it < t1) tr_finish(2048, (bfu*)((char*)wa + WA_W2), it, v, tl);
      else if (it < t1 + t2) tr_finish(4096, (bfu*)((char*)wa + WA_WO2), it - t1, v, tl);
      else if (it < t1 + t2 + t3) tr_finish(512, (bfu*)((char*)wa + WA_UQ), it - t1 - t2, v, tl);
      else tr_finish(256, (bfu*)((char*)wa + WA_UKV), it - t1 - t2 - t3, v, tl);
    };
    f32x4 va[4], vb[4];
    int it = b;
    if (it < tot) ld_(it, va);
    while (it < tot) {
      const int nx = it + G_;
      if (nx < tot) ld_(nx, vb);
      fin_(it, va);
#pragma unroll
      for (int i = 0; i < 4; ++i) va[i] = vb[i];
      it = nx;
    }
  }
}

DI void row_ln(float (&v)[32], const float* __restrict__ g, const float* __restrict__ bta, int lane) {
  float sm = 0.f;
#pragma unroll
  for (int i = 0; i < 32; ++i) sm += v[i];
  const float mean = wsum(sm) * (1.f / DM);
  float sq = 0.f;
#pragma unroll
  for (int i = 0; i < 32; ++i) { v[i] -= mean; sq += v[i] * v[i]; }
  const float rstd = rsqrtf(wsum(sq) * (1.f / DM) + EPS);
#pragma unroll
  for (int j = 0; j < 8; ++j) {
    const f32x4 gg = *(const f32x4*)(g + lane * 4 + 256 * j), bb = *(const f32x4*)(bta + lane * 4 + 256 * j);
#pragma unroll
    for (int e = 0; e < 4; ++e) v[4 * j + e] = v[4 * j + e] * rstd * gg[e] + bb[e];
  }
}
DI void phase_mod(const Params& p, int g, int layer, char* smem) {
  (void)smem;
  const int tid = TID(), lane = tid & 63, w = tid >> 6;
  bfu* h = (bfu*)(OPQ(p.ws + WS_G) + (layer == 0 ? L0_H : L1_H));
  for (int i = blockIdx.x * 4 + w; i < MG; i += gridDim.x * 4) {
    const long r = (long)g * MG + i; const int b = (int)(r / T), t = (int)(r % T);
    float v[32];
    if (layer == 0) {
      const float* s = t < CTX ? p.ctx() + ((long)b * CTX + t) * DM : p.x() + ((long)b * SEQ + (t - CTX)) * DM;
#pragma unroll
      for (int j = 0; j < 8; ++j) { const f32x4 a = *(const f32x4*)(s + lane * 4 + 256 * j); v[4 * j] = a[0]; v[4 * j + 1] = a[1]; v[4 * j + 2] = a[2]; v[4 * j + 3] = a[3]; }
    } else {
      float* s = P_ZX + r * DM;
#pragma unroll
      for (int j = 0; j < 8; ++j) { const f32x4 a = *(const f32x4*)(s + lane * 4 + 256 * j); v[4 * j] = a[0]; v[4 * j + 1] = a[1]; v[4 * j + 2] = a[2]; v[4 * j + 3] = a[3]; }
      row_ln(v, p.ln_g(), p.ln_b(), lane);
#pragma unroll
      for (int j = 0; j < 8; ++j) { const f32x4 o = {v[4 * j], v[4 * j + 1], v[4 * j + 2], v[4 * j + 3]}; *(f32x4*)(s + lane * 4 + 256 * j) = o; }
    }
    const float* md = P_MOD + ((long)layer * 9 + (t < CTX ? 8 : b)) * 6144;
#pragma unroll
    for (int j = 0; j < 8; ++j) {
      const f32x4 sh = *(const f32x4*)(md + lane * 4 + 256 * j), sc = *(const f32x4*)(md + 2048 + lane * 4 + 256 * j);
      u32x2 o = {cvtpk(v[4 * j] * (1.f + sc[0]) + sh[0], v[4 * j + 1] * (1.f + sc[1]) + sh[1]), cvtpk(v[4 * j + 2] * (1.f + sc[2]) + sh[2], v[4 * j + 3] * (1.f + sc[3]) + sh[3])};
      *reinterpret_cast<u32x2*>(h + (long)i * DM + lane * 4 + 256 * j) = o;
    }
  }
}
DI void phase_final(const Params& p, char* smem) {
  (void)smem;
  const int tid = TID(), lane = tid & 63, w = tid >> 6;
  for (int i = blockIdx.x * 4 + w; i < NB * SEQ; i += gridDim.x * 4) {
    const int b = i / SEQ, pos = i % SEQ;
    const float* s = P_ZX + ((long)b * T + CTX + pos) * DM;
    float v[32];
#pragma unroll
    for (int j = 0; j < 8; ++j) { const f32x4 a = *(const f32x4*)(s + lane * 4 + 256 * j); v[4 * j] = a[0]; v[4 * j + 1] = a[1]; v[4 * j + 2] = a[2]; v[4 * j + 3] = a[3]; }
    row_ln(v, p.ln_g() + DM, p.ln_b() + DM, lane);
    float* d = p.out + (long)i * DM;
#pragma unroll
    for (int j = 0; j < 8; ++j) { const f32x4 o = {v[4 * j], v[4 * j + 1], v[4 * j + 2], v[4 * j + 3]}; *(f32x4*)(d + lane * 4 + 256 * j) = o; }
  }
}

DI void gemm_tile(const bfu* __restrict__ A, int lda, const bfu* __restrict__ Bt, int ldb, int K, char* smem) {
  const int tid = TID(), lane = tid & 63, w = tid >> 6, wm = w >> 1, wn = w & 1, l32 = lane & 31, hi = lane >> 5;
  bfu* As = (bfu*)smem; bfu* Bs = As + 2 * 128 * LDT;
  const int sr = tid >> 3, sc = (tid & 7) * 8;
  const bfu* Ag = A + (long)sr * lda + sc; const bfu* Bg = Bt + (long)sr * ldb + sc;
  bf16x8 ra0[4], rb0[4], ra1[4], rb1[4];
#define G_LOAD(RA, RB, kt_)                                                                              \
  _Pragma("unroll") for (int i = 0; i < 4; ++i) { RA[i] = ld8(Ag + (long)(32 * i) * lda + (kt_) * BK); RB[i] = ld8(Bg + (long)(32 * i) * ldb + (kt_) * BK); }
#define G_STORE(RA, RB, buf_)                                                                            \
  _Pragma("unroll") for (int i = 0; i < 4; ++i) { st8(As + (buf_) * 128 * LDT + (sr + 32 * i) * LDT + sc, RA[i]); st8(Bs + (buf_) * 128 * LDT + (sr + 32 * i) * LDT + sc, RB[i]); }
#define G_COMPUTE(buf_)                                                                                  \
  do {                                                                                                   \
    const bfu* as = As + (buf_) * 128 * LDT + (wm * 64 + l32) * LDT + hi * 8;                            \
    const bfu* bs = Bs + (buf_) * 128 * LDT + (wn * 64 + l32) * LDT + hi * 8;                            \
    _Pragma("unroll") for (int ks = 0; ks < 4; ++ks) {                                                   \
      bf16x8 a0 = ld8(as + ks * 16), a1 = ld8(as + 32 * LDT + ks * 16), b0 = ld8(bs + ks * 16), b1 = ld8(bs + 32 * LDT + ks * 16); \
      acc[0][0] = MFMA(a0, b0, acc[0][0]); acc[0][1] = MFMA(a0, b1, acc[0][1]);                          \
      acc[1][0] = MFMA(a1, b0, acc[1][0]); acc[1][1] = MFMA(a1, b1, acc[1][1]);                          \
    }                                                                                                    \
  } while (0)
  const int nk = K / BK;
  G_LOAD(ra0, rb0, 0);
  G_LOAD(ra1, rb1, 1);
  f32x16 acc[2][2];
#pragma unroll
  for (int i = 0; i < 2; ++i)
#pragma unroll
    for (int j = 0; j < 2; ++j)
#pragma unroll
      for (int r = 0; r < 16; ++r) acc[i][j][r] = 0.f;
  __syncthreads();
  G_STORE(ra0, rb0, 0);
  if (2 < nk) { G_LOAD(ra0, rb0, 2); }
  __syncthreads();
  for (int kt = 0; kt < nk; kt += 2) {
    G_COMPUTE(0);
    G_STORE(ra1, rb1, 1);
    if (kt + 3 < nk) { G_LOAD(ra1, rb1, kt + 3); }
    __syncthreads();
    G_COMPUTE(1);
    if (kt + 2 < nk) { G_STORE(ra0, rb0, 0); }
    if (kt + 4 < nk) { G_LOAD(ra0, rb0, kt + 4); }
    __syncthreads();
  }
#undef G_LOAD
#undef G_STORE
#undef G_COMPUTE
  float* Cs = (float*)smem;
#pragma unroll
  for (int mi = 0; mi < 2; ++mi)
#pragma unroll
    for (int ni = 0; ni < 2; ++ni)
#pragma unroll
      for (int r = 0; r < 16; ++r) Cs[(wm * 64 + mi * 32 + crow(r, hi)) * CLD + wn * 64 + ni * 32 + l32] = acc[mi][ni][r];
  __syncthreads();
}
DI void gemm_preload(const bfu* __restrict__ A, const bfu* __restrict__ Bt, int K, int kt, bf16x8 (&ra)[4], bf16x8 (&rb)[8]) {
  const int tid = TID(), sr = tid >> 3, sc = (tid & 7) * 8;
  const bfu* Ag = A + (long)sr * K + sc + kt * BK; const bfu* Bg = Bt + (long)sr * K + sc + kt * BK;
#pragma unroll
  for (int i = 0; i < 4; ++i) ra[i] = ld8(Ag + (long)(32 * i) * K);
#pragma unroll
  for (int i = 0; i < 8; ++i) rb[i] = ld8(Bg + (long)(32 * i) * K);
}
DI void gemm_main2(const bfu* __restrict__ A, const bfu* __restrict__ Bt, int K, char* smem, f32x16 (&acc)[2][4], bf16x8 (&ra)[4], bf16x8 (&rb)[8]) {
  const int tid = TID(), lane = tid & 63, w = tid >> 6, wm = w >> 1, wn = w & 1, l32 = lane & 31, hi = lane >> 5;
  bfu* As = (bfu*)smem; bfu* Bs = As + 128 * LDT;
  const int sr = tid >> 3, sc = (tid & 7) * 8;
#pragma unroll
  for (int i = 0; i < 2; ++i)
#pragma unroll
    for (int j = 0; j < 4; ++j)
#pragma unroll
      for (int r = 0; r < 16; ++r) acc[i][j][r] = 0.f;
  const int nk = K / BK;
  const bfu* as = As + (wm * 64 + l32) * LDT + hi * 8;
  const bfu* bs = Bs + (wn * 128 + l32) * LDT + hi * 8;
  for (int kt = 0; kt < nk; ++kt) {
    __syncthreads();
#pragma unroll
    for (int i = 0; i < 4; ++i) st8(As + (sr + 32 * i) * LDT + sc, ra[i]);
#pragma unroll
    for (int i = 0; i < 8; ++i) st8(Bs + (sr + 32 * i) * LDT + sc, rb[i]);
    __syncthreads();
    if (kt + 1 < nk) gemm_preload(A, Bt, K, kt + 1, ra, rb);
#pragma unroll
    for (int ks = 0; ks < 4; ++ks) {
      const bf16x8 a0 = ld8(as + ks * 16), a1 = ld8(as + 32 * LDT + ks * 16);
#pragma unroll
      for (int j = 0; j < 4; ++j) {
        const bf16x8 b = ld8(bs + j * 32 * LDT + ks * 16);
        acc[0][j] = MFMA(a0, b, acc[0][j]); acc[1][j] = MFMA(a1, b, acc[1][j]);
      }
    }
  }
}
DI void acc_half_to_lds(float* Cs, const f32x16 (&acc)[2][4], int h) {
  const int tid = TID(), lane = tid & 63, w = tid >> 6, wm = w >> 1, wn = w & 1, l32 = lane & 31, hi = lane >> 5;
  __syncthreads();
  if (wn == h) {
#pragma unroll
    for (int mi = 0; mi < 2; ++mi)
#pragma unroll
      for (int ni = 0; ni < 4; ++ni)
#pragma unroll
        for (int r = 0; r < 16; ++r) Cs[(wm * 64 + mi * 32 + crow(r, hi)) * CLD + ni * 32 + l32] = acc[mi][ni][r];
  }
  __syncthreads();
}
DI void ldrow8(const float* Cs, int row, int c, float* v) {
  f32x4 a = *(const f32x4*)(Cs + row * CLD + c), b = *(const f32x4*)(Cs + row * CLD + c + 4);
  for (int j = 0; j < 4; ++j) { v[j] = a[j]; v[4 + j] = b[j]; }
}
DI void store_R(const float* Cs, int cb, int nc, bfu* dst, long ld, float scale, const float* rs = nullptr) {
  const int cpr = nc >> 3;
  for (int u = TID(); u < 128 * cpr; u += NT) {
    int row = u / cpr, c8 = (u % cpr) * 8; float v[8]; ldrow8(Cs, row, cb + c8, v);
    float s = rs ? scale * rs[row] : scale;
    for (int j = 0; j < 8; ++j) v[j] *= s;
    st8(dst + row * ld + c8, pack8f(v));
  }
}
DI void store_T(const float* Cs, int cb, int nc, bfu* dst, long ldT, float scale, const float* rs = nullptr) {
  for (int u = TID(); u < nc * 16; u += NT) {
    int c = u % nc, rc = (u / nc) * 8; float v[8];
    for (int j = 0; j < 8; ++j) v[j] = Cs[(rc + j) * CLD + cb + c] * (rs ? scale * rs[rc + j] : scale);
    st8(dst + c * ldT + rc, pack8f(v));
  }
}
DI void rope_inplace(float* Cs, int cb, int HALF, const float* cs, int tstride, int idx0, int pos0) {
  const int cpr = HALF >> 3;
  for (int u = TID(); u < 128 * cpr; u += NT) {
    int row = u / cpr, c8 = (u % cpr) * 8; float a[8], b[8];
    ldrow8(Cs, row, cb + c8, a); ldrow8(Cs, row, cb + HALF + c8, b);
    const float* t = cs + (long)(pos0 + row) * tstride + (idx0 + c8) * 2;
    for (int j = 0; j < 8; ++j) { float co = t[2 * j], si = t[2 * j + 1]; float x1 = a[j], x2 = b[j]; a[j] = x1 * co - x2 * si; b[j] = x1 * si + x2 * co; }
    f32x4 o;
    o = (f32x4){a[0], a[1], a[2], a[3]}; *(f32x4*)(Cs + row * CLD + cb + c8) = o;
    o = (f32x4){a[4], a[5], a[6], a[7]}; *(f32x4*)(Cs + row * CLD + cb + c8 + 4) = o;
    o = (f32x4){b[0], b[1], b[2], b[3]}; *(f32x4*)(Cs + row * CLD + cb + HALF + c8) = o;
    o = (f32x4){b[4], b[5], b[6], b[7]}; *(f32x4*)(Cs + row * CLD + cb + HALF + c8 + 4) = o;
  }
  __syncthreads();
}

DI void epi_in0(const Params& p, float* Cs, int m0, int n0) {
  char* G = OPQ(p.ws + WS_G);
  const int bg = m0 / T, t0 = m0 % T; const bool lat = t0 >= CTX;
  if (n0 < 4096) {
    const bool isq = n0 < 2048; const int head = (n0 & 2047) >> 7;
    if (lat) { rope_inplace(Cs, 0, 32, P_CS64, 64, 0, t0 - CTX); rope_inplace(Cs, 64, 32, P_CS64, 64, 0, t0 - CTX); }
    bfu* dst = (bfu*)(G + (isq ? L0_QD : L0_KD));
    for (int m = 0; m < 2; ++m) store_R(Cs, m * 64, 64, dst + ((long)(bg * 32 + head * 2 + m) * T + t0) * 64, 64, isq ? 0.125f * LOG2E : 1.f);
  } else if (n0 < 6144) {
    const int head = (n0 - 4096) >> 7;
    store_T(Cs, 0, 128, (bfu*)(G + L0_VT) + ((long)(bg * 16 + head) * 128) * T + t0, T, 1.f);
  } else if (n0 < 7168) {
    const int head = (n0 - 6144) >> 7;
    store_R(Cs, 0, 128, (bfu*)(G + L0_MQ) + ((long)(bg * 8 + head) * T + t0) * 128, 128, 0.08838834764831845f);
  } else if (n0 < 8192) {
    const int head = (n0 - 7168) >> 7;
    store_R(Cs, 0, 128, (bfu*)(G + L0_MK) + ((long)(bg * 8 + head) * T + t0) * 128, 128, 1.f);
    store_T(Cs, 0, 128, (bfu*)(G + L0_MKT) + ((long)(bg * 8 + head) * 128) * T + t0, T, 1.f);
  } else if (n0 < 10240) {
    const int head = (n0 - 8192) >> 8, d0 = (n0 - 8192) & 255;
    store_T(Cs, 0, 128, (bfu*)(G + L0_MVT) + ((long)(bg * 8 + head) * 256 + d0) * T + t0, T, 1.f);
  } else if (n0 < 12288) {
    store_R(Cs, 0, 128, (bfu*)(G + L0_OG) + (long)m0 * 2048 + (n0 - 10240), 2048, 1.f);
  } else if (n0 < 16384) {
    store_R(Cs, 0, 128, (bfu*)(G + L0_GATE) + (long)m0 * 4096 + (n0 - 12288), 4096, 1.f);
  } else {
    float* gb = (float*)(G + L0_SM + SM_GI); float* gsv = (float*)(G + L0_SM + SM_GF); float* gc = (float*)(G + L0_SM + SM_GC);
    const int tid = TID(), w = tid >> 6, lane = tid & 63;
    for (int sidx = w; sidx < 32; sidx += 4) {
      const int ch = sidx & 1, dh = sidx >> 1, dir = dh >> 3, head = dh & 7, row = ch * 64 + lane;
      const float ig = Cs[row * CLD + dir * 8 + head] + p.ab_b_if()[dir * 8 + head];
      const float f = logsig(Cs[row * CLD + 16 + dir * 8 + head] + p.ab_b_if()[16 + dir * 8 + head]);
      float bc = f;
      for (int off = 1; off < 64; off <<= 1) {
        const float yu = __shfl_up(bc, off), yd = __shfl_down(bc, off);
        const bool ok = dir == 0 ? lane >= off : lane + off < 64;
        if (ok) bc += dir == 0 ? yu : yd;
      }
      const float gs = ig - bc;
      float cm = gs;
      for (int off = 1; off < 64; off <<= 1) {
        const float yu = __shfl_up(cm, off), yd = __shfl_down(cm, off);
        const bool ok = dir == 0 ? lane >= off : lane + off < 64;
        if (ok) cm = fmaxf(cm, dir == 0 ? yu : yd);
      }
      const long o = ((long)(dir * GB + bg) * 8 + head) * T + t0 + row;
      gb[o] = bc; gsv[o] = gs; gc[o] = cm;
    }
  }
}
DI void epi_in1(const Params& p, float* Cs, int m0, int n0) {
  char* G = OPQ(p.ws + WS_G);
  const int bg = m0 / T, t0 = m0 % T; const bool lat = t0 >= CTX;
  if (n0 < 4096) {
    const bool isq = n0 < 2048; const int head = (n0 & 2047) >> 8, par = (n0 >> 7) & 1;
    if (lat) rope_inplace(Cs, 0, 64, P_CS256, 256, par * 64, t0 - CTX);
    bfu* dst = (bfu*)(G + (isq ? L1_RQ : L1_RK)) + ((long)(bg * 8 + head) * T + t0) * 256;
    const float sc = isq ? 1.f : 0.0625f;
    store_R(Cs, 0, 64, dst + par * 64, 256, sc); store_R(Cs, 64, 64, dst + 128 + par * 64, 256, sc);
    if (!isq) {
      bfu* dT = (bfu*)(G + L1_RKT) + ((long)(bg * 8 + head) * 256) * T + t0;
      store_T(Cs, 0, 64, dT + (long)(par * 64) * T, T, sc); store_T(Cs, 64, 64, dT + (long)(128 + par * 64) * T, T, sc);
    }
  } else if (n0 < 6144) {
    const int head = (n0 - 4096) >> 8, d0 = (n0 - 4096) & 255;
    store_T(Cs, 0, 128, (bfu*)(G + L1_RVT) + ((long)(bg * 8 + head) * 256 + d0) * T + t0, T, 1.f);
  } else if (n0 < 6912) {
    const bool isq = n0 < 6656; const int j = isq ? (n0 - 6144) >> 7 : (n0 - 6656) >> 7;
    if (isq) store_R(Cs, 0, 128, (bfu*)(G + L1_QL) + (long)m0 * 512 + j * 128, 512, 1.f);
    else store_R(Cs, 0, 128, (bfu*)(G + L1_KVL) + (long)m0 * 256 + j * 128, 256, 1.f);
    float* ss = (float*)(G + L1_SM + (isq ? SM_SSQ : SM_SSK));
    for (int u = TID(); u < 2048; u += NT) {
      int row = u >> 4, c8 = (u & 15) * 8; float v[8]; ldrow8(Cs, row, c8, v);
      float s = 0; for (int jj = 0; jj < 8; ++jj) s += v[jj] * v[jj];
      s += __shfl_xor(s, 1); s += __shfl_xor(s, 2); s += __shfl_xor(s, 4); s += __shfl_xor(s, 8);
      if ((u & 15) == 0) ss[(long)(m0 + row) * (isq ? 4 : 2) + j] = s;
    }
  } else if (n0 < 7040) {
    if (lat) rope_inplace(Cs, 0, 32, P_CS64, 64, 0, t0 - CTX);
    for (int hh = 0; hh < 16; ++hh) store_R(Cs, 0, 64, (bfu*)(G + L1_K) + ((long)(bg * 16 + hh) * T + t0) * 192 + 128, 192, 1.f);
  } else {
    store_R(Cs, 0, 128, (bfu*)(G + L1_GATE) + (long)m0 * 4096 + (n0 - 7040), 4096, 1.f);
  }
}
DI void epi_uq(const Params& p, float* Cs, int m0, int n0, const float* rsl) {
  char* G = OPQ(p.ws + WS_G);
  const int bg = m0 / T, t0 = m0 % T; const bool lat = t0 >= CTX;
  for (int gq = 0; gq < 2; ++gq) {
    int gi = (n0 >> 6) + gq, head = gi / 3, part = gi % 3;
    if (part == 2 && lat) rope_inplace(Cs, gq * 64, 32, P_CS64, 64, 0, t0 - CTX);
    store_R(Cs, gq * 64, 64, (bfu*)(G + L1_Q) + ((long)(bg * 16 + head) * T + t0) * 192 + part * 64, 192, 0.07216878364870323f * LOG2E, rsl);
  }
}
DI void epi_ukv(const Params& p, float* Cs, int m0, int n0, const float* rsl) {
  char* G = OPQ(p.ws + WS_G);
  const int bg = m0 / T, t0 = m0 % T; const int head = n0 >> 8;
  if ((n0 & 255) == 0) store_R(Cs, 0, 128, (bfu*)(G + L1_K) + ((long)(bg * 16 + head) * T + t0) * 192, 192, 1.f, rsl);
  else store_T(Cs, 0, 128, (bfu*)(G + L1_VT) + ((long)(bg * 16 + head) * 128) * T + t0, T, 1.f, rsl);
}
DI void epi_out(const Params& p, const float* Cs, int g, int layer, int m0, int n0) {
  for (int u0 = TID(); u0 < 2048; u0 += 2 * NT) {
    f32x4 xa[2], xb[2], ga[2], gb[2]; float* zp[2];
#pragma unroll
    for (int q = 0; q < 2; ++q) {
      const int u = u0 + q * NT, row = u >> 4, c8 = (u & 15) * 8;
      const long r = (long)g * MG + m0 + row; const int b = (int)(r / T), t = (int)(r % T);
      float* z = P_ZX + r * DM + n0 + c8;
      const float* xs = layer == 0 ? (t < CTX ? p.ctx() + ((long)b * CTX + t) * DM : p.x() + ((long)b * SEQ + (t - CTX)) * DM) + n0 + c8 : z;
      const float* gt = P_MOD + ((long)layer * 9 + (t < CTX ? 8 : b)) * 6144 + 4096 + n0 + c8;
      xa[q] = *(const f32x4*)xs; xb[q] = *(const f32x4*)(xs + 4); ga[q] = *(const f32x4*)gt; gb[q] = *(const f32x4*)(gt + 4); zp[q] = z;
    }
#pragma unroll
    for (int q = 0; q < 2; ++q) {
      const int u = u0 + q * NT, row = u >> 4, c8 = (u & 15) * 8; float v[8]; ldrow8(Cs, row, c8, v);
      f32x4 o0, o1;
      for (int j = 0; j < 4; ++j) { o0[j] = ALPHA * xa[q][j] + ga[q][j] * v[j]; o1[j] = ALPHA * xb[q][j] + gb[q][j] * v[4 + j]; }
      *(f32x4*)zp[q] = o0; *(f32x4*)(zp[q] + 4) = o1;
    }
  }
}

DI void store_T_regs(const f32x16 (&acc)[2][4], int h, bfu* dst, const float* rs) {
  const int tid = TID(), lane = tid & 63, w = tid >> 6, wm = w >> 1, wn = w & 1, l32 = lane & 31, hi = lane >> 5;
  if (wn != h) return;
#pragma unroll
  for (int mi = 0; mi < 2; ++mi)
#pragma unroll
    for (int ni = 0; ni < 4; ++ni)
#pragma unroll
      for (int rg = 0; rg < 4; ++rg) {
        const int row = wm * 64 + mi * 32 + 8 * rg + 4 * hi;
        float s0 = 1.f, s1 = 1.f, s2 = 1.f, s3 = 1.f;
        if (rs) { s0 = rs[row]; s1 = rs[row + 1]; s2 = rs[row + 2]; s3 = rs[row + 3]; }
        const u32x2 v = {cvtpk(acc[mi][ni][4 * rg] * s0, acc[mi][ni][4 * rg + 1] * s1), cvtpk(acc[mi][ni][4 * rg + 2] * s2, acc[mi][ni][4 * rg + 3] * s3)};
        *reinterpret_cast<u32x2*>(dst + (long)(ni * 32 + l32) * T + row) = v;
      }
}
DI int nt_map0(int v) { return v < 16 ? 24 + v : (v == 16 ? 64 : (v < 41 ? v - 17 : v - 1)); }
DI void phase_gemm(const Params& p, int g, int kind, char* smem, float* rsl, int* s_item, int vlo, int vhi, int cslot) {
  char* G = OPQ(p.ws + WS_G); float* Cs = (float*)smem;
  const int MT = MG / 128;
  int ntn, nvalid;
  if (kind == 0) { ntn = (N1 + 255) / 256; nvalid = N1 / 128; } else if (kind == 1) { ntn = (N2 + 255) / 256; nvalid = N2 / 128; }
  else if (kind == 2) { ntn = 12 + 16; nvalid = 56; } else { ntn = 8; nvalid = 16; }
  (void)ntn;
  const int nvt = vhi - vlo, total = MT * nvt;
  const int xcd = blockIdx.x & 7;
  int* qctr = P_CTR + 256 + (g * 8 + cslot) * 8 + xcd;
  struct TD { const bfu* A; const bfu* Bt; int K, m0, n0, nt; bool ok; };
  auto fetch = [&](TD& d) {
    for (;;) {
      __syncthreads();
      if (TID() == 0) *s_item = atomicAdd(qctr, 1);
      __syncthreads();
      const int kq = *s_item;
      const int tile = ((kq >> 6) * 8 + xcd) * 64 + (kq & 63);
      if (tile >= total) { d.ok = false; return; }
      const int strip = tile / (MT * 8), rem = tile - strip * (MT * 8);
      const int wdt = min(8, nvt - strip * 8);
      const int mt = rem / wdt, vt = vlo + strip * 8 + rem % wdt;
      d.nt = kind == 0 ? nt_map0(vt) : vt; d.m0 = mt * 128; d.n0 = d.nt * 256;
      if (kind == 0) { d.A = (const bfu*)(G + L0_H) + (long)d.m0 * 2048; d.Bt = P_WA + (long)d.n0 * 2048; d.K = 2048; }
      else if (kind == 1) { d.A = (const bfu*)(G + L1_H) + (long)d.m0 * 2048; d.Bt = (const bfu*)((char*)P_WA + WA_W2) + (long)d.n0 * 2048; d.K = 2048; }
      else if (kind == 2) {
        if (d.nt < 12) { d.A = (const bfu*)(G + L1_QL) + (long)d.m0 * 512; d.Bt = (const bfu*)((char*)P_WA + WA_UQ) + (long)d.n0 * 512; d.K = 512; }
        else { d.n0 -= 12 * 256; d.A = (const bfu*)(G + L1_KVL) + (long)d.m0 * 256; d.Bt = (const bfu*)((char*)P_WA + WA_UKV) + (long)d.n0 * 256; d.K = 256; }
      } else {
        const int layer = kind - 3;
        if (layer == 1 && (d.m0 % T) < CTX) continue;
        d.A = (const bfu*)(G + (layer == 0 ? L0_MIX : L1_MIX)) + (long)d.m0 * 4096;
        d.Bt = (layer == 0 ? P_WO1 : (const bfu*)((char*)P_WA + WA_WO2)) + (long)d.n0 * 4096; d.K = 4096;
      }
      d.ok = true; return;
    }
  };
  TD cur; fetch(cur);
  bf16x8 ra[4], rb[8];
  if (cur.ok) gemm_preload(cur.A, cur.Bt, cur.K, 0, ra, rb);
  while (cur.ok) {
    const int m0 = cur.m0, n0 = cur.n0, nt = cur.nt;
    if (kind == 2) {
      const bool uq = nt < 12;
      __syncthreads();
      if (TID() < 128) {
        float s;
        if (uq) { const float* q = (const float*)(G + L1_SM + SM_SSQ) + (long)(m0 + TID()) * 4; s = (q[0] + q[1] + q[2] + q[3]) * (1.f / 512.f); }
        else { const float* q = (const float*)(G + L1_SM + SM_SSK) + (long)(m0 + TID()) * 2; s = (q[0] + q[1]) * (1.f / 256.f); }
        rsl[TID()] = rsqrtf(s + EPS);
      }
    }
    f32x16 acc[2][4];
    gemm_main2(cur.A, cur.Bt, cur.K, smem, acc, ra, rb);
    TD nxt; fetch(nxt);
    if (nxt.ok) gemm_preload(nxt.A, nxt.Bt, nxt.K, 0, ra, rb);
#pragma unroll
    for (int h = 0; h < 2; ++h) {
      if (nt * 2 + h >= nvalid) break;
      const int nh = n0 + h * 128;
      {
        const int bgq = m0 / T, t0q = m0 % T; bfu* td = nullptr; const float* trs = nullptr;
        if (kind == 0 && nh >= 4096 && nh < 6144) td = (bfu*)(G + L0_VT) + ((long)(bgq * 16 + ((nh - 4096) >> 7)) * 128) * T + t0q;
        else if (kind == 0 && nh >= 8192 && nh < 10240) td = (bfu*)(G + L0_MVT) + ((long)(bgq * 8 + ((nh - 8192) >> 8)) * 256 + ((nh - 8192) & 255)) * T + t0q;
        else if (kind == 1 && nh >= 4096 && nh < 6144) td = (bfu*)(G + L1_RVT) + ((long)(bgq * 8 + ((nh - 4096) >> 8)) * 256 + ((nh - 4096) & 255)) * T + t0q;
        else if (kind == 2 && nt >= 12 && (nh & 255) == 128) { td = (bfu*)(G + L1_VT) + ((long)(bgq * 16 + (nh >> 8)) * 128) * T + t0q; trs = rsl; }
        if (td) { store_T_regs(acc, h, td, trs); continue; }
      }
      acc_half_to_lds(Cs, acc, h);
      if (kind == 0) epi_in0(p, Cs, m0, nh);
      else if (kind == 1) epi_in1(p, Cs, m0, nh);
      else if (kind == 2) { if (nt < 12) epi_uq(p, Cs, m0, nh, rsl); else epi_ukv(p, Cs, m0, nh, rsl); }
      else epi_out(p, Cs, g, kind - 3, m0, nh);
    }
    cur = nxt;
  }
}

template <int DK, int KT>
DI void attn_item(const bfu* __restrict__ Qp, const bfu* __restrict__ Kp, const bfu* __restrict__ Vtp, int nkeys, bfu* __restrict__ Op, int ldo, char* smem) {
  constexpr int LK = DK + 8, LV = KT + 8, NKS = DK / 16, CPR = DK / 8, KCH = KT * CPR / NT, VPR = KT / 8, VCH = 128 * VPR / NT, NBK = KT / 32;
  bfu* Ks = (bfu*)smem; bfu* Vs = Ks + KT * LK;
  const int tid = TID(), lane = tid & 63, w = tid >> 6, l32 = lane & 31, hi = lane >> 5;
  bf16x8 qf[NKS];
  {
    const bfu* qrow = Qp + (long)(w * 32 + l32) * DK + hi * 8;
#pragma unroll
    for (int ks = 0; ks < NKS; ++ks) qf[ks] = ld8(qrow + ks * 16);
  }
  f32x16 o[4];
#pragma unroll
  for (int d = 0; d < 4; ++d)
#pragma unroll
    for (int r = 0; r < 16; ++r) o[d][r] = 0.f;
  float m = -1e30f, lsum = 0.f;
  bf16x8 kr[KCH], vr[VCH];
#define ATT_LOADK(key0)                                                                                  \
  do {                                                                                                   \
    _Pragma("unroll") for (int i = 0; i < KCH; ++i) { int c = tid + NT * i; kr[i] = ld8(Kp + (long)((key0) + c / CPR) * DK + (c % CPR) * 8); } \
  } while (0)
#define ATT_LOADV(key0)                                                                                  \
  do {                                                                                                   \
    _Pragma("unroll") for (int i = 0; i < VCH; ++i) { int c = tid + NT * i; vr[i] = ld8(Vtp + (long)(c / VPR) * T + (key0) + (c % VPR) * 8); }  \
  } while (0)
  ATT_LOADK(0); ATT_LOADV(0);
  const int NTL = nkeys / KT;
  for (int j = 0; j < NTL; ++j) {
    __syncthreads();
#pragma unroll
    for (int i = 0; i < KCH; ++i) { int c = tid + NT * i; st8(Ks + (c / CPR) * LK + (c % CPR) * 8, kr[i]); }
#pragma unroll
    for (int i = 0; i < VCH; ++i) { int c = tid + NT * i; st8(Vs + (c / VPR) * LV + (c % VPR) * 8, vr[i]); }
    __syncthreads();
    if (j + 1 < NTL) ATT_LOADK((j + 1) * KT);
    f32x16 sv[NBK];
#pragma unroll
    for (int bk = 0; bk < NBK; ++bk)
#pragma unroll
      for (int r = 0; r < 16; ++r) sv[bk][r] = 0.f;
    const bfu* k0p = Ks + l32 * LK + hi * 8;
#pragma unroll
    for (int ks = 0; ks < NKS; ++ks)
#pragma unroll
      for (int bk = 0; bk < NBK; ++bk) sv[bk] = MFMA(ld8(k0p + bk * 32 * LK + ks * 16), qf[ks], sv[bk]);
    float mx = sv[0][0];
#pragma unroll
    for (int bk = 0; bk < NBK; ++bk)
#pragma unroll
      for (int r = 0; r < 16; ++r) mx = fmaxf(mx, sv[bk][r]);
    mx = fmaxf(mx, __shfl_xor(mx, 32));
    float mn = m, alpha = 1.f;
    const bool moved = __builtin_amdgcn_ballot_w64(mx > m + 8.f) != 0ull;
    if (moved) { mn = fmaxf(m, mx); alpha = __builtin_amdgcn_exp2f(m - mn); m = mn; }
    float rs = 0.f;
#pragma unroll
    for (int bk = 0; bk < NBK; ++bk)
#pragma unroll
      for (int r = 0; r < 16; ++r) { sv[bk][r] = __builtin_amdgcn_exp2f(sv[bk][r] - mn); rs += sv[bk][r]; }
    lsum = lsum * alpha + rs;
    if (moved) {
#pragma unroll
      for (int d = 0; d < 4; ++d)
#pragma unroll
        for (int r = 0; r < 16; ++r) o[d][r] *= alpha;
    }
    bf16x8 pf[2 * NBK];
#pragma unroll
    for (int bk = 0; bk < NBK; ++bk) { pf[2 * bk] = packacc(sv[bk], 0); pf[2 * bk + 1] = packacc(sv[bk], 1); }
    if (j + 1 < NTL) ATT_LOADV((j + 1) * KT);
#pragma unroll
    for (int kk = 0; kk < 2 * NBK; ++kk)
#pragma unroll
      for (int d = 0; d < 4; ++d) o[d] = MFMA(ld44(Vs + (d * 32 + l32) * LV + kk * 16 + 4 * hi), pf[kk], o[d]);
  }
#undef ATT_LOADK
#undef ATT_LOADV
  const float inv = 1.f / (lsum + __shfl_xor(lsum, 32));
  bfu* orow = Op + (long)(w * 32 + l32) * ldo;
#pragma unroll
  for (int d = 0; d < 4; ++d)
#pragma unroll
    for (int rg = 0; rg < 4; ++rg) {
      u32x2 v = {cvtpk(o[d][4 * rg] * inv, o[d][4 * rg + 1] * inv), cvtpk(o[d][4 * rg + 2] * inv, o[d][4 * rg + 3] * inv)};
      *reinterpret_cast<u32x2*>(orow + d * 32 + 8 * rg + 4 * hi) = v;
    }
}

template <bool ML>
DI void scan_block(const Params& p, int sitem, char* smem) {
  constexpr int DKS = ML ? 128 : 256, LQ = 136, LT = 72;
  char* G = OPQ(p.ws + WS_G);
  const int tid = TID(), lane = tid & 63, w = tid >> 6, l32 = lane & 31, hi = lane >> 5;
  int half = 0, dvg = 0, dir, head, bg; bool isden = false;
  if (ML) { const int which = sitem % 3, rest = sitem / 3; dir = rest & 1; head = (rest >> 1) & 7; bg = rest >> 4; isden = which == 2; dvg = isden ? 0 : which; }
  else { half = sitem & 1; dvg = (sitem >> 1) & 1; const int rest = sitem >> 2; dir = rest & 1; head = (rest >> 1) & 7; bg = rest >> 4; }
  const long hb = (long)(bg * 8 + head);
  const bfu* q = (const bfu*)(G + (ML ? L0_MQ : L1_RQ)) + hb * T * DKS + half * 128;
  const bfu* k = (const bfu*)(G + (ML ? L0_MK : L1_RK)) + hb * T * DKS + half * 128;
  const bfu* kT = (const bfu*)(G + (ML ? L0_MKT : L1_RKT)) + (hb * DKS + half * 128) * T;
  const bfu* vT = (const bfu*)(G + (ML ? L0_MVT : L1_RVT)) + (hb * 256 + dvg * 128) * T;
  const float* gbp = (const float*)(G + L0_SM + SM_GI) + ((long)(dir * GB + bg) * 8 + head) * T;
  const float* gsp = (const float*)(G + L0_SM + SM_GF) + ((long)(dir * GB + bg) * 8 + head) * T;
  const float* gcp = (const float*)(G + L0_SM + SM_GC) + ((long)(dir * GB + bg) * 8 + head) * T;
  float* dnp = (float*)(G + L0_SM + SM_DN) + ((long)(dir * GB + bg) * 8 + head) * T;
  bfu* outp = ML ? (bfu*)(G + L0_HN) + ((long)dir * MG + (long)bg * T) * 2048 + head * 256 + dvg * 128 + w * 32
                 : (bfu*)(G + L1_R) + ((long)(dir * 2 + half) * MG + (long)bg * T) * 2048 + head * 256 + dvg * 128 + w * 32;
  bfu* qS = (bfu*)smem; bfu* kS = qS + 64 * LQ; bfu* kTS = kS + 64 * LQ; bfu* vTS = kTS + 128 * LT; float* wsm = (float*)(vTS + 128 * LT);
  float lg2 = 0.f;
  if (!ML) lg2 = logsig(p.ret_decay()[dir * 8 + head]) * LOG2E;
  const bf16x8 ones = {0x3F80, 0x3F80, 0x3F80, 0x3F80, 0x3F80, 0x3F80, 0x3F80, 0x3F80};
  const bool active = !isden || w == 0;
  const int r16 = tid >> 4, c16 = (tid & 15) * 8, r8 = tid >> 3, c8 = (tid & 7) * 8;
  bf16x8 ra[4], rb[4];
  float bN = 0.f, gsN = 0.f, cmN = 0.f;
#define SC_LOAD_QK(p0_)                                                                                   \
  do {                                                                                                    \
    _Pragma("unroll") for (int i = 0; i < 4; ++i) {                                                       \
      ra[i] = ld8(q + (long)((p0_) + r16 + 16 * i) * DKS + c16); rb[i] = ld8(k + (long)((p0_) + r16 + 16 * i) * DKS + c16); \
    }                                                                                                     \
    if (ML && w == 0) { bN = gbp[(p0_) + lane]; gsN = gsp[(p0_) + lane]; cmN = gcp[(p0_) + lane]; }      \
  } while (0)
#define SC_STORE_QK()                                                                                     \
  _Pragma("unroll") for (int i = 0; i < 4; ++i) { st8(qS + (r16 + 16 * i) * LQ + c16, ra[i]); st8(kS + (r16 + 16 * i) * LQ + c16, rb[i]); }
#define SC_LOAD_T(p0_)                                                                                    \
  _Pragma("unroll") for (int i = 0; i < 4; ++i) {                                                         \
    ra[i] = ld8(kT + (long)(r8 + 32 * i) * T + (p0_) + c8);                                               \
    rb[i] = isden ? ones : ld8(vT + (long)(r8 + 32 * i) * T + (p0_) + c8);                                \
  }
#define SC_STORE_T()                                                                                      \
  _Pragma("unroll") for (int i = 0; i < 4; ++i) { st8(kTS + (r8 + 32 * i) * LT + c8, ra[i]); st8(vTS + (r8 + 32 * i) * LT + c8, rb[i]); }
#define SC_CHUNK(ci_) (dir == 0 ? (ci_) : ((ci_) < 4 ? 3 - (ci_) : 39 - (ci_)))
  __syncthreads();
  if (!ML && tid < 64) {
    wsm[128 + tid] = __builtin_amdgcn_exp2f(lg2 * (dir == 0 ? (float)(tid + 1) : (float)(64 - tid)));
    wsm[192 + tid] = __builtin_amdgcn_exp2f(lg2 * (dir == 0 ? (float)(63 - tid) : (float)tid));
    wsm[tid] = __builtin_amdgcn_exp2f(lg2 * (dir == 0 ? (float)tid : -(float)tid));
    wsm[64 + tid] = __builtin_amdgcn_exp2f(lg2 * (dir == 0 ? -(float)tid : (float)tid));
    if (tid == 0) wsm[320] = __builtin_amdgcn_exp2f(lg2 * 64.f);
  }
  SC_LOAD_QK(SC_CHUNK(0) * 64);
  SC_STORE_QK();
  SC_LOAD_T(SC_CHUNK(0) * 64);
  f32x16 C[4];
#pragma unroll
  for (int i = 0; i < 4; ++i)
#pragma unroll
    for (int r = 0; r < 16; ++r) C[i][r] = 0.f;
  float mst = 0.f;
  for (int ci = 0; ci < 36; ++ci) {
    const int p0 = SC_CHUNK(ci) * 64;
    __syncthreads();
    SC_STORE_T();
    const float b = bN, gs = gsN, cm = cmN;
    if (ci + 1 < 36) SC_LOAD_QK(SC_CHUNK(ci + 1) * 64);
    if (ML && w == 0) {
      const float bend = __uint_as_float(dir == 0 ? __builtin_amdgcn_readlane(__float_as_uint(b), 63) : __builtin_amdgcn_readlane(__float_as_uint(b), 0));
      const float gmx = __uint_as_float(dir == 0 ? __builtin_amdgcn_readlane(__float_as_uint(cm), 63) : __builtin_amdgcn_readlane(__float_as_uint(cm), 0));
      const float inter = b + mst, mt = fmaxf(b + cm, inter), a = __expf(inter - mt);
      const float mnew = fmaxf(bend + mst, bend + gmx);
      wsm[lane] = b - mt; wsm[64 + lane] = gs; wsm[128 + lane] = a; wsm[192 + lane] = __expf(bend + gs - mnew); wsm[256 + lane] = __expf(-mt);
      if (lane == 0) wsm[320] = __expf(bend + mst - mnew);
      mst = mnew;
    }
    __syncthreads();
    if (active) {
      const int tbx = dir == 0 ? 1 : 0, sbx = 1 - tbx;
      f32x16 out0, out1;
#pragma unroll
      for (int r = 0; r < 16; ++r) { out0[r] = 0.f; out1[r] = 0.f; }
      {
        const bfu* qa = qS + l32 * LQ + 4 * hi; const bfu* qb = qa + 32 * LQ;
#pragma unroll
        for (int i = 0; i < 4; ++i)
#pragma unroll
          for (int s2 = 0; s2 < 2; ++s2) {
            const bf16x8 cf = packacc(C[i], s2);
            out0 = MFMA(cf, ld44(qa + 32 * i + 16 * s2), out0);
            out1 = MFMA(cf, ld44(qb + 32 * i + 16 * s2), out1);
          }
      }
      {
        const float sct0 = wsm[128 + l32], sct1 = wsm[160 + l32];
#pragma unroll
        for (int r = 0; r < 16; ++r) { out0[r] *= sct0; out1[r] *= sct1; }
      }
      const bfu* v0 = vTS + (w * 32 + l32) * LT + 4 * hi; const bfu* v1 = v0 + 32;
      const float sB0 = wsm[l32], sB1 = wsm[32 + l32];
      {
        f32x16 sd0, sx;
#pragma unroll
        for (int r = 0; r < 16; ++r) { sd0[r] = 0.f; sx[r] = 0.f; }
        const bfu* k0 = kS + l32 * LQ + hi * 8; const bfu* kx = k0 + sbx * 32 * LQ;
        const bfu* q0 = qS + l32 * LQ + hi * 8; const bfu* qx = q0 + tbx * 32 * LQ;
#pragma unroll 2
        for (int ks = 0; ks < 8; ++ks) {
          sd0 = MFMA(ld8(k0 + ks * 16), ld8(q0 + ks * 16), sd0);
          sx = MFMA(ld8(kx + ks * 16), ld8(qx + ks * 16), sx);
        }
        const float sBx = tbx ? sB1 : sB0;
#pragma unroll
        for (int r = 0; r < 16; ++r) {
          const int sl = crow(r, hi);
          const bool valid = dir == 0 ? sl <= l32 : sl >= l32;
          float w0, wx;
          if (ML) { w0 = __expf(sB0 + wsm[64 + sl]); wx = __expf(sBx + wsm[64 + sbx * 32 + sl]); }
          else { w0 = sB0 * wsm[64 + sl]; wx = sBx * wsm[64 + sbx * 32 + sl]; }
          sd0[r] = valid ? sd0[r] * w0 : 0.f; sx[r] *= wx;
        }
#pragma unroll
        for (int s2 = 0; s2 < 2; ++s2) out0 = MFMA(ld44(v0 + 16 * s2), packacc(sd0, s2), out0);
        if (dir == 0) {
#pragma unroll
          for (int s2 = 0; s2 < 2; ++s2) out1 = MFMA(ld44(v0 + 16 * s2), packacc(sx, s2), out1);
        } else {
#pragma unroll
          for (int s2 = 0; s2 < 2; ++s2) out0 = MFMA(ld44(v1 + 16 * s2), packacc(sx, s2), out0);
        }
      }
      {
        f32x16 sa, sb_;
#pragma unroll
        for (int r = 0; r < 16; ++r) { sa[r] = 0.f; sb_[r] = 0.f; }
        const bfu* k1 = kS + (32 + l32) * LQ + hi * 8; const bfu* q1 = qS + (32 + l32) * LQ + hi * 8;
#pragma unroll 2
        for (int ks = 0; ks < 8; ks += 2) {
          sa = MFMA(ld8(k1 + ks * 16), ld8(q1 + ks * 16), sa);
          sb_ = MFMA(ld8(k1 + ks * 16 + 16), ld8(q1 + ks * 16 + 16), sb_);
        }
#pragma unroll
        for (int r = 0; r < 16; ++r) {
          const int sl = crow(r, hi);
          const bool valid = dir == 0 ? sl <= l32 : sl >= l32;
          float w1;
          if (ML) w1 = __expf(sB1 + wsm[96 + sl]);
          else w1 = sB1 * wsm[96 + sl];
          sa[r] = valid ? (sa[r] + sb_[r]) * w1 : 0.f;
        }
#pragma unroll
        for (int s2 = 0; s2 < 2; ++s2) out1 = MFMA(ld44(v1 + 16 * s2), packacc(sa, s2), out1);
      }
      if (!isden) {
        bfu* orow0 = outp + (long)(p0 + l32) * 2048; bfu* orow1 = orow0 + 32 * 2048;
#pragma unroll
        for (int rg = 0; rg < 4; ++rg) {
          u32x2 va = {cvtpk(out0[4 * rg], out0[4 * rg + 1]), cvtpk(out0[4 * rg + 2], out0[4 * rg + 3])};
          u32x2 vb = {cvtpk(out1[4 * rg], out1[4 * rg + 1]), cvtpk(out1[4 * rg + 2], out1[4 * rg + 3])};
          *reinterpret_cast<u32x2*>(orow0 + 8 * rg + 4 * hi) = va;
          *reinterpret_cast<u32x2*>(orow1 + 8 * rg + 4 * hi) = vb;
        }
      } else if (hi == 0) {
        dnp[p0 + l32] = fmaxf(fabsf(out0[0]), wsm[256 + l32]);
        dnp[p0 + 32 + l32] = fmaxf(fabsf(out1[0]), wsm[288 + l32]);
      }
    }
    __syncthreads();
    if (ci + 1 < 36) { SC_STORE_QK(); SC_LOAD_T(SC_CHUNK(ci + 1) * 64); }
    if (active) {
      const float decay = wsm[320];
#pragma unroll
      for (int i = 0; i < 4; ++i)
#pragma unroll
        for (int r = 0; r < 16; ++r) C[i][r] *= decay;
#pragma unroll
      for (int s4 = 0; s4 < 4; ++s4) {
        float vf[8];
        unpack8(ld8(vTS + (w * 32 + l32) * LT + s4 * 16 + hi * 8), vf);
#pragma unroll
        for (int j = 0; j < 8; ++j) {
          const int s = s4 * 16 + hi * 8 + j;
          vf[j] *= wsm[192 + s];
        }
        const bf16x8 bfr = pack8f(vf);
#pragma unroll
        for (int i = 0; i < 4; ++i) C[i] = MFMA(ld8(kTS + (32 * i + l32) * LT + s4 * 16 + hi * 8), bfr, C[i]);
      }
    }
  }
#undef SC_LOAD_QK
#undef SC_STORE_QK
#undef SC_LOAD_T
#undef SC_STORE_T
#undef SC_CHUNK
}

template <int layer, int part>
DI void phase_mix(const Params& p, int cidx, char* smem, int* s_item) {
  char* G = OPQ(p.ws + WS_G);
  const int tid = TID(), w = tid >> 6;
  const int xcd = blockIdx.x & 7;
  const int nscan_all = layer == 0 ? GB * 8 * 2 * 3 : GB * 8 * 2 * 4;
  const int nscan = part == 1 ? 0 : (nscan_all - xcd + 7) >> 3;
  const int natt = part == 0 ? 0 : (layer == 0 ? 8 * 18 : 4 * 16);
  int* ctr = P_CTR + (cidx + (part == 1 ? 16 : 0)) * 8 + xcd;
  int item;
#define NEXT_ITEM()                                             \
  do {                                                          \
    __syncthreads();                                            \
    if (tid == 0) *s_item = atomicAdd(ctr, 1);                  \
    __syncthreads();                                            \
    item = *s_item;                                             \
  } while (0)
  const int nsb = layer == 0 ? 12 : 16;
  const bool scanner = part != 1 && ((int)gridDim.x != 512 || (int)(blockIdx.x >> 3) < nsb);
  if (scanner || part != 0) NEXT_ITEM(); else item = 1 << 30;
  while (scanner && item < nscan) {
    const int sib = layer == 0 ? 3 : 4;
    const int sitem = (xcd + 8 * (item / sib)) * sib + item % sib;
    __builtin_amdgcn_s_setprio(3);
    if (layer == 0) scan_block<true>(p, sitem, smem);
    else scan_block<false>(p, sitem, smem);
    __builtin_amdgcn_s_setprio(0);
    NEXT_ITEM();
  }
  while (item < nscan + natt) {
    int a = item - nscan;
    if (layer == 0) {
      int pl, t0, nkeys;
      if (a < 128) { pl = a >> 4; t0 = CTX + (a & 15) * 128; nkeys = T; }
      else { a -= 128; pl = a >> 1; t0 = (a & 1) * 128; nkeys = CTX; }
      const int bh = (pl >> 1) * 8 + xcd, bg = bh >> 4, hv = (bh & 15) * 2 + (pl & 1);
      attn_item<64, 64>((const bfu*)(G + L0_QD) + ((long)(bg * 32 + hv) * T + t0) * 64, (const bfu*)(G + L0_KD) + (long)(bg * 32 + hv) * T * 64,
                    (const bfu*)(G + L0_VT) + (long)(bg * 16 + (hv >> 1)) * 128 * T, nkeys, (bfu*)(G + L0_OA) + ((long)bg * T + t0) * 4096 + hv * 128, 4096, smem);
    } else {
      const int pl = a >> 4, t0 = CTX + (a & 15) * 128;
      const int pair = pl * 8 + xcd, bg = pair >> 4, h = pair & 15;
      attn_item<192, 64>((const bfu*)(G + L1_Q) + ((long)(bg * 16 + h) * T + t0) * 192, (const bfu*)(G + L1_K) + (long)(bg * 16 + h) * T * 192,
                     (const bfu*)(G + L1_VT) + (long)(bg * 16 + h) * 128 * T, T, (bfu*)(G + L1_OA) + ((long)bg * T + t0) * 2048 + h * 128, 2048, smem);
    }
    NEXT_ITEM();
  }
#undef NEXT_ITEM
}

DI void phase_comb0(const Params& p, char* smem) {
  char* G = OPQ(p.ws + WS_G);
  const int tid = TID(), c0 = tid * 8;
  float* sl = (float*)smem;
  __syncthreads();
  if (tid < 64) {
    float a = wsum(p.diff_lam()[tid] * p.diff_lam()[64 + tid]), b = wsum(p.diff_lam()[128 + tid] * p.diff_lam()[192 + tid]);
    if (tid == 0) sl[0] = __expf(a) - __expf(b) + 0.2f;
  }
  __syncthreads();
  const float lam = sl[0];
  const bfu* Oa = (const bfu*)(G + L0_OA); const bfu* Hn = (const bfu*)(G + L0_HN); const bfu* og = (const bfu*)(G + L0_OG);
  const bfu* gate = (const bfu*)(G + L0_GATE); const float* dn = (const float*)(G + L0_SM + SM_DN); bfu* mix = (bfu*)(G + L0_MIX);
  float gd[8], gm[8];
  for (int j = 0; j < 8; ++j) { gd[j] = p.diff_g()[c0 + j]; gm[j] = p.mlstm_g()[c0 + j]; }
  for (int i = blockIdx.x; i < MG; i += gridDim.x) {
    const int bg = i / T, t = i % T;
    const bf16x8 r_o1 = ld8(Oa + (long)i * 4096 + ((c0 >> 7) * 2) * 128 + (c0 & 127)), r_o2 = ld8(Oa + (long)i * 4096 + ((c0 >> 7) * 2 + 1) * 128 + (c0 & 127));
    const bf16x8 r_g0 = ld8(gate + (long)i * 4096 + c0), r_g1 = ld8(gate + (long)i * 4096 + 2048 + c0);
    const bf16x8 r_h0 = ld8(Hn + (long)i * 2048 + c0), r_h1 = ld8(Hn + ((long)MG + i) * 2048 + c0), r_og = ld8(og + (long)i * 2048 + c0);
    const float r_d0 = dn[((long)(0 * GB + bg) * 8 + (c0 >> 8)) * T + t], r_d1 = dn[((long)(1 * GB + bg) * 8 + (c0 >> 8)) * T + t];
    float o[8];
    {
      float o1[8], o2[8], gt[8];
      unpack8(r_o1, o1); unpack8(r_o2, o2);
      unpack8(r_g0, gt);
      float ss = 0;
      for (int j = 0; j < 8; ++j) { o1[j] -= lam * o2[j]; ss += o1[j] * o1[j]; }
      ss += __shfl_xor(ss, 1); ss += __shfl_xor(ss, 2); ss += __shfl_xor(ss, 4); ss += __shfl_xor(ss, 8);
      const float rms = rsqrtf(ss * (1.f / 128.f) + EPS) * 0.8f;
      for (int j = 0; j < 8; ++j) o[j] = o1[j] * rms * gd[j] * silu(gt[j]);
      st8(mix + (long)i * 4096 + c0, pack8f(o));
    }
    {
      float h0[8], h1[8], gt[8], ov[8];
      unpack8(r_h0, h0); unpack8(r_h1, h1);
      unpack8(r_g1, gt); unpack8(r_og, ov);
      const float d0 = 1.f / r_d0, d1 = 1.f / r_d1;
      float sm = 0;
      for (int j = 0; j < 8; ++j) { h0[j] = h0[j] * d0 + h1[j] * d1; sm += h0[j]; }
      sm += __shfl_xor(sm, 1); sm += __shfl_xor(sm, 2); sm += __shfl_xor(sm, 4); sm += __shfl_xor(sm, 8); sm += __shfl_xor(sm, 16);
      const float mean = sm * (1.f / 256.f);
      float sq = 0;
      for (int j = 0; j < 8; ++j) { h0[j] -= mean; sq += h0[j] * h0[j]; }
      sq += __shfl_xor(sq, 1); sq += __shfl_xor(sq, 2); sq += __shfl_xor(sq, 4); sq += __shfl_xor(sq, 8); sq += __shfl_xor(sq, 16);
      const float rstd = rsqrtf(sq * (1.f / 256.f) + EPS);
      for (int j = 0; j < 8; ++j) o[j] = h0[j] * rstd * gm[j] * sigm(ov[j]) * silu(gt[j]);
      st8(mix + (long)i * 4096 + 2048 + c0, pack8f(o));
    }
  }
}
DI void phase_comb1(const Params& p) {
  char* G = OPQ(p.ws + WS_G);
  const int tid = TID(), c0 = tid * 8;
  const bfu* Oa = (const bfu*)(G + L1_OA); const bfu* R = (const bfu*)(G + L1_R); const bfu* gate = (const bfu*)(G + L1_GATE); bfu* mix = (bfu*)(G + L1_MIX);
  float gr[8];
  for (int j = 0; j < 8; ++j) gr[j] = p.ret_g()[c0 + j];
  for (int i = blockIdx.x; i < MG; i += gridDim.x) {
    if ((i % T) < CTX) continue;
    const bf16x8 r0 = ld8(R + (long)i * 2048 + c0), r1 = ld8(R + ((long)MG + i) * 2048 + c0), r2 = ld8(R + ((long)2 * MG + i) * 2048 + c0), r3 = ld8(R + ((long)3 * MG + i) * 2048 + c0);
    const bf16x8 rg0 = ld8(gate + (long)i * 4096 + c0), rg1 = ld8(gate + (long)i * 4096 + 2048 + c0), roa = ld8(Oa + (long)i * 2048 + c0);
    float o[8];
    {
      float h0[8], h1[8], gt[8];
      float h2[8], h3[8];
      unpack8(r0, h0); unpack8(r1, h1);
      unpack8(r2, h2); unpack8(r3, h3); unpack8(rg0, gt);
      float sm = 0;
      for (int j = 0; j < 8; ++j) { h0[j] = (h0[j] + h1[j]) + (h2[j] + h3[j]); sm += h0[j]; }
      sm += __shfl_xor(sm, 1); sm += __shfl_xor(sm, 2); sm += __shfl_xor(sm, 4); sm += __shfl_xor(sm, 8); sm += __shfl_xor(sm, 16);
      const float mean = sm * (1.f / 256.f);
      float sq = 0;
      for (int j = 0; j < 8; ++j) { h0[j] -= mean; sq += h0[j] * h0[j]; }
      sq += __shfl_xor(sq, 1); sq += __shfl_xor(sq, 2); sq += __shfl_xor(sq, 4); sq += __shfl_xor(sq, 8); sq += __shfl_xor(sq, 16);
      const float rstd = rsqrtf(sq * (1.f / 256.f) + EPS);
      for (int j = 0; j < 8; ++j) o[j] = h0[j] * rstd * gr[j] * silu(gt[j]);
      st8(mix + (long)i * 4096 + c0, pack8f(o));
    }
    {
      float a[8], gt[8];
      unpack8(roa, a); unpack8(rg1, gt);
      for (int j = 0; j < 8; ++j) o[j] = a[j] * silu(gt[j]);
      st8(mix + (long)i * 4096 + 2048 + c0, pack8f(o));
    }
  }
}

template <int OP, int LAYER>
__global__ void __launch_bounds__(NT) phase_kernel(KArgs ka, int g) {
  __shared__ __attribute__((aligned(16))) char smem[SMEM_BYTES];
  __shared__ float rsl[128];
  __shared__ int s_item;
  __shared__ unsigned long long s_ptrs[24];
  if (threadIdx.x < 22) s_ptrs[threadIdx.x] = (unsigned long long)ka.in[threadIdx.x];
  __syncthreads();
  Params p; p.sp = s_ptrs; p.out = ka.out; p.ws = ka.ws;
  if (OP == 0) phase_prep0(p, smem);
  else if (OP == 1) phase_mod(p, g, LAYER, smem);
  else if (OP == 2) phase_gemm(p, g, LAYER, smem, rsl, &s_item, 0, LAYER == 0 ? 65 : 44, 0);
  else if (OP == 3) phase_gemm(p, g, 2, smem, rsl, &s_item, 0, 28, 1);
  else if (OP == 4) phase_mix<LAYER, 2>(p, LAYER * 8 + g, smem, &s_item);
  else if (OP == 5) { if (LAYER == 0) phase_comb0(p, smem); else phase_comb1(p); }
  else if (OP == 6) phase_gemm(p, g, 3 + LAYER, smem, rsl, &s_item, 0, 8, 2);
  else if (OP == 7) phase_prep1(p, smem);
  else phase_final(p, smem);
}

#if !MULTI
#define XB_TMO      128
#define XB_XCNT(j)  (256  + 64 * (j))
#define XB_XSUB(j)  (1280 + 64 * (j))
#define XB_XGEN(j)  (2304 + 64 * (j))
#define XB_TOP      3328
#define XB_TOPGEN   3392
#define XCD_BAR_WORDS 3456
#define XB_SPIN_CAP (1u << 18)
#define LAS __attribute__((address_space(3)))

__device__ __forceinline__ unsigned xb_ld(unsigned* p)              { return __hip_atomic_load(p, __ATOMIC_RELAXED, __HIP_MEMORY_SCOPE_AGENT); }
__device__ __forceinline__ unsigned xb_add(unsigned* p, unsigned v) { return __hip_atomic_fetch_add(p, v, __ATOMIC_RELAXED, __HIP_MEMORY_SCOPE_AGENT); }
__device__ __forceinline__ unsigned xb_xcc_id() { return (unsigned)__builtin_amdgcn_s_getreg((3 << 11) | 20) & 0xFu; }
#define XB_SPIN(cond, bar) do { unsigned _sp = 0; while (cond) { __builtin_amdgcn_s_sleep(1); \
    if ((++_sp & 255u) == 0u) { if (xb_ld(&(bar)[XB_TMO])) break; if (_sp > XB_SPIN_CAP) { atomicAdd(&(bar)[XB_TMO], 1u); break; } } } } while (0)

struct XcdBarrier {
    unsigned* bar; unsigned x;
    volatile LAS unsigned* st;
};

__device__ __forceinline__ XcdBarrier xcd_barrier_post(unsigned* bar, volatile LAS unsigned* st) {
    XcdBarrier b; b.bar = bar; b.x = xb_xcc_id(); b.st = st;
    if (threadIdx.x == 0) (void)xb_add(&bar[XB_XCNT(b.x)], 1u);
    return b;
}
__device__ __forceinline__ void xcd_barrier_complete(unsigned* bar, unsigned x, unsigned& nloc, unsigned& nx) {
    const unsigned G = gridDim.x * gridDim.y * gridDim.z;
    unsigned sum, cnt, mine, sp = 0u;
    for (;;) {
        sum = 0u; cnt = 0u; mine = 0u;
#pragma unroll
        for (unsigned j = 0; j < 16; ++j) { const unsigned c = xb_ld(&bar[XB_XCNT(j)]); sum += c; cnt += (c > 0u) ? 1u : 0u; mine = (j == x) ? c : mine; }
        if (sum == G) break;
        __builtin_amdgcn_s_sleep(1);
        if ((++sp & 255u) == 0u) { if (xb_ld(&bar[XB_TMO])) break; if (sp > XB_SPIN_CAP) { atomicAdd(&bar[XB_TMO], 1u); break; } }
    }
    nloc = mine > 0u ? mine : 1u; nx = cnt > 0u ? cnt : 1u;
}

__device__ __forceinline__ void xcd_barrier(const XcdBarrier& b) {
    asm volatile("s_waitcnt vmcnt(0)" ::: "memory");
    __syncthreads();
    if (threadIdx.x == 0) {
        unsigned* bar = b.bar;
        __builtin_amdgcn_s_waitcnt(0);
        unsigned nloc = b.st[0], nx = b.st[1];
        if (nloc == 0u) { xcd_barrier_complete(bar, b.x, nloc, nx); b.st[0] = nloc; b.st[1] = nx; }
        const unsigned old = xb_add(&bar[XB_XSUB(b.x)], 1u);
        const unsigned gen = old / nloc;
        if (old + 1u == (gen + 1u) * nloc) {
            __builtin_amdgcn_fence(__ATOMIC_RELEASE, "agent");
            asm volatile("s_waitcnt vmcnt(0)" ::: "memory");
            const unsigned og = xb_add(&bar[XB_TOP], 1u);
            const unsigned tg = og / nx;
            if (og + 1u == (tg + 1u) * nx) xb_add(&bar[XB_TOPGEN], 1u);
            else XB_SPIN(xb_ld(&bar[XB_TOPGEN]) == tg, bar);
            __builtin_amdgcn_fence(__ATOMIC_ACQUIRE, "agent");
            xb_add(&bar[XB_XGEN(b.x)], 1u);
            asm volatile("s_waitcnt vmcnt(0)" ::: "memory");
        } else {
            XB_SPIN(xb_ld(&bar[XB_XGEN(b.x)]) == gen, bar);
            __builtin_amdgcn_fence(__ATOMIC_ACQUIRE, "agent");
            asm volatile("s_waitcnt vmcnt(0)" ::: "memory");
        }
    }
    __syncthreads();
}


__global__ void __launch_bounds__(NT, 2) mega(KArgs ka) {
  __shared__ __attribute__((aligned(16))) char smem[SMEM_BYTES];
  __shared__ float rsl[128];
  __shared__ int s_item;
  __shared__ unsigned long long s_ptrs[24];
  if (threadIdx.x < 22) s_ptrs[threadIdx.x] = (unsigned long long)ka.in[threadIdx.x];
  __syncthreads();
  Params p; p.sp = s_ptrs; p.out = ka.out; p.ws = ka.ws;
  cg::grid_group grid = cg::this_grid();
  __shared__ uint4 xb_words;
  if (threadIdx.x == 0) xb_words = make_uint4(0u, 0u, 0u, 0u);
  __syncthreads();
  {
    const XcdBarrier xb0 = xcd_barrier_post((unsigned*)(ka.ws + WS_BAR), (volatile LAS unsigned*)&xb_words);
    if (threadIdx.x == 0) xb_words.z = xb0.x;
  }
  __syncthreads();
#ifndef REPG
#define REPG 1
#endif
#ifndef REPM
#define REPM 1
#endif
#ifndef REPE
#define REPE 1
#endif
#ifndef REPS
#define REPS 1
#endif
#define GSYNC() for (int rs_ = 0; rs_ < REPS; ++rs_) { XcdBarrier xb; xb.bar = (unsigned*)(OPQ(p.ws) + WS_BAR); xb.st = (volatile LAS unsigned*)&xb_words; xb.x = xb.st[2]; xcd_barrier(xb); }
  for (int r_ = 0; r_ < REPE; ++r_) phase_prep0(p, smem);
  if (ka.ws == nullptr) grid.sync();
  GSYNC();
  phase_mod(p, 0, 0, smem);
  GSYNC();
  phase_gemm(p, 0, 0, smem, rsl, &s_item, 0, 28, 0);
  GSYNC();
  for (int g = 0; g < NG; ++g) {
    phase_mix<0, 0>(p, g, smem, &s_item);
    phase_gemm(p, g, 0, smem, rsl, &s_item, 28, 65, 1);
    GSYNC();
    phase_mix<0, 1>(p, g, smem, &s_item);
    GSYNC();
    phase_comb0(p, smem);
    if (g + 1 < NG) phase_mod(p, g + 1, 0, smem);
    GSYNC();
    phase_gemm(p, g, 3, smem, rsl, &s_item, 0, 8, 2);
    if (g + 1 < NG) phase_gemm(p, g + 1, 0, smem, rsl, &s_item, 0, 28, 0);
    else { phase_prep1(p, smem); phase_mod(p, 0, 1, smem); }
    GSYNC();
  }
  for (int g = 0; g < NG; ++g) {
    phase_gemm(p, g, 1, smem, rsl, &s_item, 0, 28, 3);
    GSYNC();
    phase_mix<1, 0>(p, 8 + g, smem, &s_item);
    phase_gemm(p, g, 1, smem, rsl, &s_item, 28, 44, 4);
    phase_gemm(p, g, 2, smem, rsl, &s_item, 0, 28, 5);
    GSYNC();
    phase_mix<1, 1>(p, 8 + g, smem, &s_item);
    GSYNC();
    phase_comb1(p);
    GSYNC();
    phase_gemm(p, g, 4, smem, rsl, &s_item, 0, 8, 6);
    if (g + 1 < NG) phase_mod(p, g + 1, 1, smem);
    GSYNC();
  }
  phase_final(p, smem);
}

#endif

extern "C" void kernel_launch(void* const* d_in, const int* in_sizes, int n_in, void* d_out, int out_size, void* d_ws, size_t ws_size, hipStream_t stream) {
  static int grid_blocks = 0;
  if (!grid_blocks) {
    int dev = 0, cus = 0, per_cu = 0;
    hipGetDevice(&dev);
    hipDeviceGetAttribute(&cus, hipDeviceAttributeMultiprocessorCount, dev);
#if !MULTI
    hipOccupancyMaxActiveBlocksPerMultiprocessor(&per_cu, mega, NT, 0);
#else
    per_cu = 2;
#endif
    if (per_cu > 2) per_cu = 2;
    grid_blocks = (cus * per_cu / 8) * 8;
    if (ws_size < WS_END) fprintf(stderr, "kernel_launch: workspace too small: %zu < %zu\n", ws_size, (size_t)WS_END);
  }
  if (ws_size < WS_END || grid_blocks <= 0) return;
  KArgs p{};
  for (int i = 0; i < 22; ++i) p.in[i] = (const float*)d_in[i];
  p.out = (float*)d_out;
  p.ws = (char*)d_ws;
#if MULTI
  const int GRD = 512;
#define LAUNCH(OP, LY, g) hipLaunchKernelGGL((phase_kernel<OP, LY>), dim3(GRD), dim3(NT), 0, stream, p, g)
  LAUNCH(0, 0, 0);
  for (int g = 0; g < NG; ++g) { LAUNCH(1, 0, g); LAUNCH(2, 0, g); LAUNCH(4, 0, g); LAUNCH(5, 0, g); LAUNCH(6, 0, g); }
  LAUNCH(7, 0, 0);
  for (int g = 0; g < NG; ++g) { LAUNCH(1, 1, g); LAUNCH(2, 1, g); LAUNCH(3, 1, g); LAUNCH(4, 1, g); LAUNCH(5, 1, g); LAUNCH(6, 1, g); }
  LAUNCH(8, 0, 0);
#else
  (void)hipMemsetAsync((char*)d_ws + WS_CTR, 0, 4096 + 16384, stream);
  void* args[] = {&p};
  hipError_t e = hipLaunchCooperativeKernel((void*)mega, dim3(grid_blocks), dim3(NT), args, 0, stream);
  if (e != hipSuccess) fprintf(stderr, "cooperative launch failed: %s (grid %d)\n", hipGetErrorString(e), grid_blocks);
#endif
}
```
